# Optimizing an MI355X kernel written in HIP

```python
import jax, jax.numpy as jnp
from jax import lax
import numpy as np

D_MODEL = 1024
BATCH = 2
SEQ = 8192
DEPTH = 1

GLA_HEADS = 4
GLA_VAL_WIDTH = D_MODEL // 2
GLA_DV = GLA_VAL_WIDTH // GLA_HEADS
GLA_DK = GLA_DV // 2
GLA_KEY_WIDTH = GLA_HEADS * GLA_DK
GLA_GATE_RANK = 16
GLA_TAU = 16.0
GLA_CHUNK = 64
ATT_WIDTH = D_MODEL - GLA_VAL_WIDTH
ATT_HEAD_DIM = 64
ATT_HEADS = ATT_WIDTH // ATT_HEAD_DIM
ROT_DIM = ATT_HEAD_DIM // 4
ROPE_THETA = 500000.0
DILATED_PATTERNS = ((128, 1), (512, 4), (2048, 16))
MIX_WIDTH = GLA_VAL_WIDTH + ATT_WIDTH
IN_WIDTH = 2 * GLA_KEY_WIDTH + 2 * GLA_VAL_WIDTH + 2 * GLA_GATE_RANK + 3 * ATT_WIDTH
MOE_GROUPS = 4
MOE_EXPERTS_PER_GROUP = 8
MOE_N_EXPERTS = MOE_GROUPS * MOE_EXPERTS_PER_GROUP
MOE_TOP_K = 2
MOE_D_FF = D_MODEL // 2
MOE_BLOCK = 128
EPS = 1e-6
NEG_INF = -1e30

kernel_name = 'hybrid_gla_dilated_attn_hier_moe'


def _rmsnorm(x, w):
    xf = x.astype(jnp.float32)
    y = xf * lax.rsqrt(jnp.mean(xf * xf, axis=-1, keepdims=True) + EPS)
    return (y * w.astype(jnp.float32)).astype(x.dtype)


def _gla_one_direction(q, k, v, log_a):
    B, H, S, dk = q.shape
    dv = v.shape[-1]
    C = GLA_CHUNK
    n = S // C
    q = q.reshape(B, H, n, C, dk)
    k = k.reshape(B, H, n, C, dk)
    v = v.reshape(B, H, n, C, dv)
    b = jnp.cumsum(log_a.reshape(B, H, n, C, dk), axis=-2)
    b_last = b[..., -1:, :]
    q_dec = q * jnp.exp(b)
    k_inv = k * jnp.exp(-b)
    k_end = k * jnp.exp(b_last - b)
    lower = jnp.tril(jnp.ones((C, C), dtype=bool))
    attn = jnp.where(lower, jnp.einsum('bhncd,bhnsd->bhncs', q_dec, k_inv), 0.0)
    o_intra = jnp.einsum('bhncs,bhnsv->bhncv', attn, v)
    chunk_kv = jnp.einsum('bhncd,bhncv->bhndv', k_end, v)
    chunk_decay = jnp.exp(b_last[..., 0, :])

    def step(state, inp):
        kv_n, dec_n = inp
        return state * dec_n[..., None] + kv_n, state

    init = jnp.zeros((B, H, dk, dv), jnp.float32)
    _, states = lax.scan(step, init, (jnp.moveaxis(chunk_kv, 2, 0), jnp.moveaxis(chunk_decay, 2, 0)))
    states = jnp.moveaxis(states, 0, 2)
    o_inter = jnp.einsum('bhncd,bhndv->bhncv', q_dec, states)
    return (o_intra + o_inter).reshape(B, H, S, dv)


def _gla_mixer(q, k, v, g_out, lr_f, lr_b, wf, bf, wb, bb, norm_w):
    B, S, _ = q.shape
    f32 = jnp.float32

    def heads(t, d):
        return t.reshape(B, S, GLA_HEADS, d).transpose(0, 2, 1, 3).astype(f32)

    qh = heads(q, GLA_DK) * (GLA_DK ** -0.5)
    kh = heads(k, GLA_DK)
    vh = heads(v, GLA_DV)
    log_a_f = heads(jax.nn.log_sigmoid(lr_f.astype(f32) @ wf.astype(f32) + bf.astype(f32)), GLA_DK) / GLA_TAU
    log_a_b = heads(jax.nn.log_sigmoid(lr_b.astype(f32) @ wb.astype(f32) + bb.astype(f32)), GLA_DK) / GLA_TAU

    def flip(t):
        return jnp.flip(t, axis=2)

    o = _gla_one_direction(qh, kh, vh, log_a_f) + flip(
        _gla_one_direction(flip(qh), flip(kh), flip(vh), flip(log_a_b)))
    o = o.transpose(0, 2, 1, 3)
    gate = g_out.reshape(B, S, GLA_HEADS, GLA_DV).astype(f32)
    o = _rmsnorm(o, norm_w) * jax.nn.silu(gate)
    return o.reshape(B, S, GLA_VAL_WIDTH).astype(q.dtype)


def _rope_tables(S):
    inv = ROPE_THETA ** (-(jnp.arange(0, ROT_DIM, 2, dtype=jnp.float32) / ROT_DIM))
    ang = jnp.arange(S, dtype=jnp.float32)[:, None] * inv[None, :]
    return jnp.cos(ang), jnp.sin(ang)


def _apply_partial_rope(t, cos, sin):
    half = ROT_DIM // 2
    t1 = t[..., :half]
    t2 = t[..., half:ROT_DIM]
    c = cos[None, :, None, :]
    s = sin[None, :, None, :]
    return jnp.concatenate([t1 * c - t2 * s, t2 * c + t1 * s, t[..., ROT_DIM:]], axis=-1)


def _banded_attention(q, k, v, radius):
    N, L, hd = q.shape
    R = radius
    nb = -(-L // R)
    Lp = nb * R
    q_p = jnp.pad(q, ((0, 0), (0, Lp - L), (0, 0))).reshape(N, nb, R, hd)
    k_p = jnp.pad(k, ((0, 0), (R, Lp - L + R), (0, 0))).reshape(N, nb + 2, R, hd)
    v_p = jnp.pad(v, ((0, 0), (R, Lp - L + R), (0, 0))).reshape(N, nb + 2, R, hd)
    k_win = jnp.concatenate([k_p[:, :-2], k_p[:, 1:-1], k_p[:, 2:]], axis=2)
    v_win = jnp.concatenate([v_p[:, :-2], v_p[:, 1:-1], v_p[:, 2:]], axis=2)
    s = jnp.einsum('nbqd,nbkd->nbqk', q_p, k_win) * (hd ** -0.5)
    qpos = (jnp.arange(nb)[:, None] * R + jnp.arange(R)[None, :])[:, :, None]
    kpos = (jnp.arange(nb)[:, None] * R - R + jnp.arange(3 * R)[None, :])[:, None, :]
    valid = (jnp.abs(qpos - kpos) <= R) & (kpos >= 0) & (kpos < L)
    s = jnp.where(valid, s, NEG_INF)
    m = jnp.max(s, axis=-1, keepdims=True)
    p = jnp.exp(s - m)
    z = jnp.sum(p, axis=-1, keepdims=True)
    o = jnp.einsum('nbqk,nbkd->nbqd', p / z, v_win)
    lse = (m + jnp.log(z))[..., 0]
    return o.reshape(N, Lp, hd)[:, :L], lse.reshape(N, Lp)[:, :L]


def _dilated_attention(q, k, v, window, dilation):
    B, S, H, hd = q.shape
    L = S // dilation

    def to_classes(t):
        return t.reshape(B, L, dilation, H, hd).transpose(0, 2, 3, 1, 4).reshape(B * dilation * H, L, hd)

    o, lse = _banded_attention(to_classes(q), to_classes(k), to_classes(v), window // (2 * dilation))
    o = o.reshape(B, dilation, H, L, hd).transpose(0, 3, 1, 2, 4).reshape(B, S, H, hd)
    lse = lse.reshape(B, dilation, H, L).transpose(0, 3, 1, 2).reshape(B, S, H)
    return o, lse


def _dilated_mixer(q, k, v):
    B, S, _ = q.shape
    cos, sin = _rope_tables(S)

    def heads(t):
        return t.reshape(B, S, ATT_HEADS, ATT_HEAD_DIM).astype(jnp.float32)

    qh = _apply_partial_rope(heads(q), cos, sin)
    kh = _apply_partial_rope(heads(k), cos, sin)
    vh = heads(v)
    outs, lses = [], []
    for window, dilation in DILATED_PATTERNS:
        o, lse = _dilated_attention(qh, kh, vh, window, dilation)
        outs.append(o)
        lses.append(lse)
    w = jax.nn.softmax(jnp.stack(lses, axis=0), axis=0)
    o = jnp.einsum('pbsh,pbshd->bshd', w, jnp.stack(outs, axis=0))
    return o.reshape(B, S, ATT_WIDTH).astype(q.dtype)


def _hier_moe(h, wg, bg, we, be, w_gate, w_up, w_down):
    T, D = h.shape
    f32 = jnp.float32
    hf = h.astype(f32)
    g_logits = hf @ wg.astype(f32) + bg.astype(f32)
    g_prob = jax.nn.softmax(g_logits, axis=-1)
    g_sel = jnp.argmax(g_logits, axis=-1)
    rows = jnp.arange(T)
    g_w = g_prob[rows, g_sel]
    e_logits = jnp.einsum('td,gde->tge', hf, we.astype(f32)) + be.astype(f32)
    e_sel_logits = e_logits[rows, g_sel]
    top_v, top_i = lax.top_k(e_sel_logits, MOE_TOP_K)
    weights = g_w[:, None] * jax.nn.softmax(top_v, axis=-1)
    expert = g_sel[:, None] * MOE_EXPERTS_PER_GROUP + top_i

    A = T * MOE_TOP_K
    e_flat = expert.reshape(-1)
    tok_flat = jnp.repeat(rows, MOE_TOP_K)
    w_flat = weights.reshape(-1)
    order = jnp.argsort(e_flat)
    e_s, tok_s, w_s = e_flat[order], tok_flat[order], w_flat[order]
    counts = jnp.zeros((MOE_N_EXPERTS,), jnp.int32).at[e_flat].add(1)
    padded = ((counts + MOE_BLOCK - 1) // MOE_BLOCK) * MOE_BLOCK
    start = jnp.cumsum(counts) - counts
    pend = jnp.cumsum(padded)
    pstart = pend - padded
    dest = pstart[e_s] + (jnp.arange(A) - start[e_s])
    n_blocks = -(-A // MOE_BLOCK) + MOE_N_EXPERTS
    cap = n_blocks * MOE_BLOCK
    buf_tok = jnp.full((cap,), T, jnp.int32).at[dest].set(tok_s.astype(jnp.int32))
    h_pad = jnp.concatenate([h, jnp.zeros((1, D), h.dtype)], axis=0)
    xb = h_pad[buf_tok].reshape(n_blocks, MOE_BLOCK, D)
    block_expert = jnp.clip(jnp.searchsorted(pend, jnp.arange(n_blocks) * MOE_BLOCK, side='right'),
                            0, MOE_N_EXPERTS - 1)

    def expert_block(args):
        xblk, eid = args
        return (jax.nn.silu(xblk @ w_gate[eid]) * (xblk @ w_up[eid])) @ w_down[eid]

    yb = lax.map(expert_block, (xb, block_expert)).reshape(cap, D)
    y_s = yb[dest] * w_s[:, None].astype(h.dtype)
    return jnp.zeros((T, D), h.dtype).at[tok_s].add(y_s)


def setup_inputs(seed: int = 0) -> dict:
    key = jax.random.key(seed)
    ks = jax.random.split(key, 18)

    def nrm(k, shape, scale):
        return jax.random.normal(k, shape, jnp.float32) * scale

    return {
        'x': nrm(ks[0], (BATCH, SEQ, D_MODEL), 1.0),
        'norm1_w': 1.0 + nrm(ks[1], (DEPTH, D_MODEL), 0.02),
        'w_in': nrm(ks[2], (DEPTH, D_MODEL, IN_WIDTH), D_MODEL ** -0.5),
        'gla_fwd_gate_w': nrm(ks[3], (DEPTH, GLA_GATE_RANK, GLA_KEY_WIDTH), GLA_GATE_RANK ** -0.5),
        'gla_fwd_gate_b': nrm(ks[4], (DEPTH, GLA_KEY_WIDTH), 0.1),
        'gla_bwd_gate_w': nrm(ks[5], (DEPTH, GLA_GATE_RANK, GLA_KEY_WIDTH), GLA_GATE_RANK ** -0.5),
        'gla_bwd_gate_b': nrm(ks[6], (DEPTH, GLA_KEY_WIDTH), 0.1),
        'gla_norm_w': 1.0 + nrm(ks[7], (DEPTH, GLA_DV), 0.02),
        'w_out': nrm(ks[8], (DEPTH, MIX_WIDTH, D_MODEL), MIX_WIDTH ** -0.5),
        'norm2_w': 1.0 + nrm(ks[9], (DEPTH, D_MODEL), 0.02),
        'router_group_w': nrm(ks[10], (DEPTH, D_MODEL, MOE_GROUPS), D_MODEL ** -0.5),
        'router_group_b': nrm(ks[11], (DEPTH, MOE_GROUPS), 0.01),
        'router_expert_w': nrm(ks[12], (DEPTH, MOE_GROUPS, D_MODEL, MOE_EXPERTS_PER_GROUP), D_MODEL ** -0.5),
        'router_expert_b': nrm(ks[13], (DEPTH, MOE_GROUPS, MOE_EXPERTS_PER_GROUP), 0.01),
        'expert_w_gate': nrm(ks[14], (DEPTH, MOE_N_EXPERTS, D_MODEL, MOE_D_FF), D_MODEL ** -0.5),
        'expert_w_up': nrm(ks[15], (DEPTH, MOE_N_EXPERTS, D_MODEL, MOE_D_FF), D_MODEL ** -0.5),
        'expert_w_down': nrm(ks[16], (DEPTH, MOE_N_EXPERTS, MOE_D_FF, D_MODEL), MOE_D_FF ** -0.5),
        'final_norm_w': 1.0 + nrm(ks[17], (D_MODEL,), 0.02),
    }


def reference(x, norm1_w, w_in, gla_fwd_gate_w, gla_fwd_gate_b, gla_bwd_gate_w, gla_bwd_gate_b,
              gla_norm_w, w_out, norm2_w, router_group_w, router_group_b, router_expert_w,
              router_expert_b, expert_w_gate, expert_w_up, expert_w_down, final_norm_w):
    B, S, D = x.shape
    sizes = [GLA_KEY_WIDTH, GLA_KEY_WIDTH, GLA_VAL_WIDTH, GLA_VAL_WIDTH,
             GLA_GATE_RANK, GLA_GATE_RANK, ATT_WIDTH, ATT_WIDTH]
    split_at = [int(c) for c in np.cumsum(sizes)]
    h = x
    for l in range(DEPTH):
        u = _rmsnorm(h, norm1_w[l])
        proj = u @ w_in[l]
        gq, gk, gv, gg, glf, glb, aq, ak, av = jnp.split(proj, split_at, axis=-1)
        gla_out = _gla_mixer(gq, gk, gv, gg, glf, glb, gla_fwd_gate_w[l], gla_fwd_gate_b[l],
                             gla_bwd_gate_w[l], gla_bwd_gate_b[l], gla_norm_w[l])
        att_out = _dilated_mixer(aq, ak, av)
        mixed = jnp.concatenate([gla_out, att_out], axis=-1)
        h = h + mixed @ w_out[l]
        u = _rmsnorm(h, norm2_w[l])
        moe = _hier_moe(u.reshape(B * S, D), router_group_w[l], router_group_b[l],
                        router_expert_w[l], router_expert_b[l], expert_w_gate[l],
                        expert_w_up[l], expert_w_down[l])
        h = h + moe.reshape(B, S, D)
    return _rmsnorm(h, final_norm_w)
```

```cpp
#include <hip/hip_runtime.h>
#include <cstdio>
#include <cstdint>

typedef unsigned short bf16;
constexpr int T = 16384, SEQ = 8192, D = 1024;
constexpr int PP = 3328;
constexpr int C_GQ = 0, C_GK = 256, C_GV = 512, C_GG = 1024, C_AQ = 1536, C_AK = 2048, C_AV = 2560, C_LF = 3072, C_LB = 3088;
constexpr int INW = 3104;
constexpr size_t MiB = 1u << 20;
constexpr size_t WS_CTL = 0, WS_U = 10 * MiB, WS_PROJ = 42 * MiB, WS_KV = 146 * MiB, WS_PART = 178 * MiB, WS_YBUF = 186 * MiB,
                 WS_LIST = 250 * MiB, WS_WGT = 252 * MiB;
constexpr int CW_CNT = 1024;

__device__ __forceinline__ float bf2f(bf16 b) { return __uint_as_float(((unsigned)b) << 16); }
__device__ __forceinline__ bf16 f2bf(float f) { unsigned u = __float_as_uint(f); return (bf16)((u + 0x7fffu + ((u >> 16) & 1u)) >> 16); }
__device__ __forceinline__ float wave_sum(float v) {
#pragma unroll
    for (int o = 1; o < 64; o <<= 1) v += __shfl_xor(v, o);
    return v;
}

__global__ __launch_bounds__(256) void k_rms_bf16(const float* x, const float* w, bf16* out) {
    const int row = blockIdx.x * 4 + (threadIdx.x >> 6), lane = threadIdx.x & 63;
    const float4* xr = (const float4*)(x + (size_t)row * D) + lane;
    float4 v[4]; float s = 0.f;
#pragma unroll
    for (int j = 0; j < 4; ++j) { v[j] = xr[64 * j]; s += v[j].x * v[j].x + v[j].y * v[j].y + v[j].z * v[j].z + v[j].w * v[j].w; }
    const float rstd = rsqrtf(wave_sum(s) * (1.f / D) + 1e-6f);
#pragma unroll
    for (int j = 0; j < 4; ++j) {
        const float4 ww = ((const float4*)w)[lane + 64 * j];
        bf16* o = out + (size_t)row * D + (lane + 64 * j) * 4;
        o[0] = f2bf(v[j].x * rstd * ww.x); o[1] = f2bf(v[j].y * rstd * ww.y); o[2] = f2bf(v[j].z * rstd * ww.z); o[3] = f2bf(v[j].w * rstd * ww.w);
    }
}

template <int MODE>
__global__ __launch_bounds__(256) void k_gemm_naive(const bf16* A, int lda, const float* B, int ldb, int K, bf16* Cb, float* Cf, const float* res) {
    __shared__ float As[16][68];
    __shared__ float Bs[16][68];
    const int tx = threadIdx.x & 15, ty = threadIdx.x >> 4;
    const int m0 = blockIdx.y * 64, n0 = blockIdx.x * 64;
    float acc[4][4];
#pragma unroll
    for (int i = 0; i < 4; ++i)
#pragma unroll
        for (int j = 0; j < 4; ++j) acc[i][j] = 0.f;
    for (int k0 = 0; k0 < K; k0 += 16) {
#pragma unroll
        for (int i = 0; i < 4; ++i) { const int e = threadIdx.x + i * 256, r = e >> 4, kk = e & 15; As[kk][r] = bf2f(A[(size_t)(m0 + r) * lda + k0 + kk]); }
#pragma unroll
        for (int i = 0; i < 4; ++i) { const int e = threadIdx.x + i * 256, kk = e >> 6, c = e & 63; int n = n0 + c, oc;
            if (MODE == 0) oc = n < 1536 ? n : (n < 3072 ? n + 32 : (n < 3104 ? n - 1536 : -1)); else oc = n;
            Bs[kk][c] = oc >= 0 ? B[(size_t)(k0 + kk) * ldb + oc] : 0.f; }
        __syncthreads();
#pragma unroll
        for (int kk = 0; kk < 16; ++kk) {
            float a[4], b[4];
#pragma unroll
            for (int i = 0; i < 4; ++i) { a[i] = As[kk][ty * 4 + i]; b[i] = Bs[kk][tx * 4 + i]; }
#pragma unroll
            for (int i = 0; i < 4; ++i)
#pragma unroll
                for (int j = 0; j < 4; ++j) acc[i][j] += a[i] * b[j];
        }
        __syncthreads();
    }
#pragma unroll
    for (int i = 0; i < 4; ++i)
#pragma unroll
        for (int j = 0; j < 4; ++j) {
            const int m = m0 + ty * 4 + i, n = n0 + tx * 4 + j;
            if (MODE == 0) Cb[(size_t)m * PP + n] = f2bf(acc[i][j]);
            else Cf[(size_t)m * D + n] = res[(size_t)m * D + n] + acc[i][j];
        }
}

__device__ __forceinline__ float log_sigmoid(float x) { return fminf(x, 0.f) - log1pf(expf(-fabsf(x))); }
__global__ __launch_bounds__(128) void k_gla_naive(const bf16* proj, const float* wf, const float* bfv, const float* wb, const float* bb, float* o_dir) {
    const int combo = blockIdx.x, dir = combo & 1, h = (combo >> 1) & 3, b = combo >> 3;
    const int vc = threadIdx.x;
    const float* W = dir ? wb : wf; const float* Bv = dir ? bb : bfv;
    __shared__ float sa[16][64], sq[16][64], sk[16][64];
    float st[64];
#pragma unroll
    for (int d = 0; d < 64; ++d) st[d] = 0.f;
    float* outp = o_dir + (size_t)dir * T * 512;
    for (int s0 = 0; s0 < SEQ; s0 += 16) {
        __syncthreads();
        for (int e = threadIdx.x; e < 16 * 64; e += 128) {
            const int i = e >> 6, d = e & 63;
            const int pos = dir ? (SEQ - 1 - (s0 + i)) : (s0 + i);
            const size_t row = (size_t)(b * SEQ + pos) * PP;
            float z = Bv[h * 64 + d];
            for (int r = 0; r < 16; ++r) z += bf2f(proj[row + (dir ? C_LB : C_LF) + r]) * W[r * 256 + h * 64 + d];
            sa[i][d] = expf(log_sigmoid(z) * (1.f / 16.f));
            sq[i][d] = bf2f(proj[row + C_GQ + h * 64 + d]) * 0.125f;
            sk[i][d] = bf2f(proj[row + C_GK + h * 64 + d]);
        }
        __syncthreads();
        for (int i = 0; i < 16; ++i) {
            const int pos = dir ? (SEQ - 1 - (s0 + i)) : (s0 + i);
            const size_t tok = (size_t)(b * SEQ + pos);
            const float v = bf2f(proj[tok * PP + C_GV + h * 128 + vc]);
            float o = 0.f;
#pragma unroll
            for (int d = 0; d < 64; ++d) { st[d] = st[d] * sa[i][d] + sk[i][d] * v; o += sq[i][d] * st[d]; }
            outp[tok * 512 + h * 128 + vc] = o;
        }
    }
}
__global__ __launch_bounds__(256) void k_gla_post(const float* o_dir, const bf16* proj, const float* nw, bf16* mixed) {
    const int item = blockIdx.x * 4 + (threadIdx.x >> 6), lane = threadIdx.x & 63;
    const int tok = item >> 2, h = item & 3;
    const size_t off = (size_t)tok * 512 + h * 128;
    const float a0 = o_dir[off + lane] + o_dir[(size_t)T * 512 + off + lane], a1 = o_dir[off + 64 + lane] + o_dir[(size_t)T * 512 + off + 64 + lane];
    const float rstd = rsqrtf(wave_sum(a0 * a0 + a1 * a1) * (1.f / 128.f) + 1e-6f);
    const float g0 = bf2f(proj[(size_t)tok * PP + C_GG + h * 128 + lane]), g1 = bf2f(proj[(size_t)tok * PP + C_GG + h * 128 + 64 + lane]);
    mixed[(size_t)tok * D + h * 128 + lane] = f2bf(a0 * rstd * nw[lane] * (g0 / (1.f + expf(-g0))));
    mixed[(size_t)tok * D + h * 128 + 64 + lane] = f2bf(a1 * rstd * nw[64 + lane] * (g1 / (1.f + expf(-g1))));
}

__device__ __forceinline__ float rope_val(float x, int lane, int pos) {
    const float partner = __shfl_xor(x, 8);
    if (lane >= 16) return x;
    const int i = lane & 7;
    const float inv = (float)exp2(-(double)i * 0.125 * 18.931568569324174);
    const float ang = (float)pos * inv;
    const float c = cosf(ang), s = sinf(ang);
    return lane < 8 ? x * c - partner * s : x * c + partner * s;
}
__global__ __launch_bounds__(256) void k_attn_naive(const bf16* proj, bf16* mixed) {
    const int item = blockIdx.x * 4 + (threadIdx.x >> 6), lane = threadIdx.x & 63;
    const int tok = item >> 3, h = item & 7, b = tok / SEQ, s = tok % SEQ;
    const float q = rope_val(bf2f(proj[(size_t)tok * PP + C_AQ + h * 64 + lane]), lane, s) * 0.125f;
    float m = -1e30f, l = 0.f, o = 0.f;
    for (int p = 0; p < 3; ++p) {
        const int dil = p == 0 ? 1 : (p == 1 ? 4 : 16);
        for (int dl = -64; dl <= 64; ++dl) {
            const int ks = s + dil * dl;
            if (ks < 0 || ks >= SEQ) continue;
            const size_t kt = (size_t)(b * SEQ + ks);
            const float k = rope_val(bf2f(proj[kt * PP + C_AK + h * 64 + lane]), lane, ks);
            const float sc = wave_sum(q * k);
            const float mn = fmaxf(m, sc), al = expf(m - mn), pe = expf(sc - mn);
            l = l * al + pe; o = o * al + pe * bf2f(proj[kt * PP + C_AV + h * 64 + lane]); m = mn;
        }
    }
    mixed[(size_t)tok * D + 512 + h * 64 + lane] = f2bf(o / l);
}

__global__ __launch_bounds__(256) void k_router(const float* hbuf, const float* nw, const float* wg, const float* bg, const float* we, const float* be,
                                                bf16* u2, unsigned* cnt, int* list, float* wgt) {
    const int row = blockIdx.x * 4 + (threadIdx.x >> 6), lane = threadIdx.x & 63;
    const float4* xr = (const float4*)(hbuf + (size_t)row * D) + lane;
    float u[16]; float s = 0.f;
#pragma unroll
    for (int j = 0; j < 4; ++j) { const float4 v = xr[64 * j]; u[4 * j] = v.x; u[4 * j + 1] = v.y; u[4 * j + 2] = v.z; u[4 * j + 3] = v.w; s += v.x * v.x + v.y * v.y + v.z * v.z + v.w * v.w; }
    const float rstd = rsqrtf(wave_sum(s) * (1.f / D) + 1e-6f);
#pragma unroll
    for (int j = 0; j < 4; ++j) {
        const float4 ww = ((const float4*)nw)[lane + 64 * j];
        u[4 * j] *= rstd * ww.x; u[4 * j + 1] *= rstd * ww.y; u[4 * j + 2] *= rstd * ww.z; u[4 * j + 3] *= rstd * ww.w;
        bf16* o = u2 + (size_t)row * D + (lane + 64 * j) * 4;
#pragma unroll
        for (int c = 0; c < 4; ++c) o[c] = f2bf(u[4 * j + c]);
    }
    float gl[4];
#pragma unroll
    for (int g = 0; g < 4; ++g) { float p = 0.f;
#pragma unroll
        for (int j = 0; j < 4; ++j)
#pragma unroll
            for (int c = 0; c < 4; ++c) p += u[4 * j + c] * wg[(size_t)((lane + 64 * j) * 4 + c) * 4 + g];
        gl[g] = wave_sum(p) + bg[g]; }
    int gs = 0; float gm = gl[0];
#pragma unroll
    for (int g = 1; g < 4; ++g) if (gl[g] > gm) { gm = gl[g]; gs = g; }
    float gz = 0.f;
#pragma unroll
    for (int g = 0; g < 4; ++g) gz += expf(gl[g] - gm);
    const float gw = 1.f / gz;
    float el[8];
#pragma unroll
    for (int e = 0; e < 8; ++e) { float p = 0.f;
#pragma unroll
        for (int j = 0; j < 4; ++j)
#pragma unroll
            for (int c = 0; c < 4; ++c) p += u[4 * j + c] * we[((size_t)gs * D + (lane + 64 * j) * 4 + c) * 8 + e];
        el[e] = wave_sum(p) + be[gs * 8 + e]; }
    int i0 = 0; float v0 = el[0];
#pragma unroll
    for (int e = 1; e < 8; ++e) if (el[e] > v0) { v0 = el[e]; i0 = e; }
    int i1 = -1; float v1 = -3.0e38f;
#pragma unroll
    for (int e = 0; e < 8; ++e) if (e != i0 && el[e] > v1) { v1 = el[e]; i1 = e; }
    const float e1 = expf(v1 - v0), w0 = gw / (1.f + e1), w1 = gw * e1 / (1.f + e1);
    if (lane == 0) {
        const int ex0 = gs * 8 + i0, ex1 = gs * 8 + i1;
        const unsigned s0 = atomicAdd(cnt + ex0, 1u), s1 = atomicAdd(cnt + ex1, 1u);
        list[(size_t)ex0 * T + s0] = row * 2; list[(size_t)ex1 * T + s1] = row * 2 + 1;
        wgt[row * 2] = w0; wgt[row * 2 + 1] = w1;
    }
}

__global__ __launch_bounds__(256) void k_moe_naive(const bf16* u2, const unsigned* cnt, const int* list, const float* wgt,
                                                   const float* Wg, const float* Wu, const float* Wd, bf16* ybuf) {
    const int e = blockIdx.y, r0 = blockIdx.x * 8;
    const int n = (int)cnt[e];
    if (r0 >= n) return;
    __shared__ float X[8][1024];
    __shared__ float Aact[8][512];
    __shared__ int asg[8];
    if (threadIdx.x < 8) asg[threadIdx.x] = (r0 + threadIdx.x < n) ? list[(size_t)e * T + r0 + threadIdx.x] : -1;
    __syncthreads();
    for (int i = threadIdx.x; i < 8 * 1024; i += 256) { const int r = i >> 10, k = i & 1023; X[r][k] = asg[r] >= 0 ? bf2f(u2[(size_t)(asg[r] >> 1) * D + k]) : 0.f; }
    __syncthreads();
    const float* wg = Wg + (size_t)e * 1024 * 512; const float* wu = Wu + (size_t)e * 1024 * 512; const float* wd = Wd + (size_t)e * 512 * 1024;
    for (int cc = 0; cc < 2; ++cc) {
        const int c = threadIdx.x + 256 * cc;
        float g[8], u[8];
#pragma unroll
        for (int r = 0; r < 8; ++r) { g[r] = 0.f; u[r] = 0.f; }
        for (int k = 0; k < 1024; ++k) { const float a = wg[(size_t)k * 512 + c], bq = wu[(size_t)k * 512 + c];
#pragma unroll
            for (int r = 0; r < 8; ++r) { g[r] += X[r][k] * a; u[r] += X[r][k] * bq; } }
#pragma unroll
        for (int r = 0; r < 8; ++r) Aact[r][c] = bf2f(f2bf(g[r] / (1.f + expf(-g[r])) * u[r]));
    }
    __syncthreads();
    for (int cc = 0; cc < 4; ++cc) {
        const int c = threadIdx.x + 256 * cc;
        float y[8];
#pragma unroll
        for (int r = 0; r < 8; ++r) y[r] = 0.f;
        for (int k = 0; k < 512; ++k) { const float a = wd[(size_t)k * 1024 + c];
#pragma unroll
            for (int r = 0; r < 8; ++r) y[r] += Aact[r][k] * a; }
#pragma unroll
        for (int r = 0; r < 8; ++r) if (asg[r] >= 0) ybuf[(size_t)asg[r] * D + c] = f2bf(y[r] * wgt[asg[r]]);
    }
}

__global__ __launch_bounds__(256) void k_final(float* hbuf, const bf16* ybuf, const float* w) {
    const int row = blockIdx.x * 4 + (threadIdx.x >> 6), lane = threadIdx.x & 63;
    float4* xr = (float4*)(hbuf + (size_t)row * D) + lane;
    float u[16]; float s = 0.f;
#pragma unroll
    for (int j = 0; j < 4; ++j) { const float4 v = xr[64 * j]; u[4 * j] = v.x; u[4 * j + 1] = v.y; u[4 * j + 2] = v.z; u[4 * j + 3] = v.w; }
#pragma unroll
    for (int j = 0; j < 4; ++j)
#pragma unroll
        for (int c = 0; c < 4; ++c) {
            const size_t col = (size_t)(lane + 64 * j) * 4 + c;
            u[4 * j + c] += bf2f(ybuf[(size_t)(row * 2) * D + col]) + bf2f(ybuf[(size_t)(row * 2 + 1) * D + col]);
            s += u[4 * j + c] * u[4 * j + c];
        }
    const float rstd = rsqrtf(wave_sum(s) * (1.f / D) + 1e-6f);
#pragma unroll
    for (int j = 0; j < 4; ++j) { const float4 ww = ((const float4*)w)[lane + 64 * j];
        xr[64 * j] = make_float4(u[4 * j] * rstd * ww.x, u[4 * j + 1] * rstd * ww.y, u[4 * j + 2] * rstd * ww.z, u[4 * j + 3] * rstd * ww.w); }
}

extern "C" void kernel_launch(void* const* d_in, const int* in_sizes, int n_in, void* d_out, int out_size, void* d_ws, size_t ws_size, hipStream_t stream) {
    const float* x = (const float*)d_in[0]; const float* norm1_w = (const float*)d_in[1]; const float* w_in = (const float*)d_in[2];
    const float* wf = (const float*)d_in[3]; const float* bfv = (const float*)d_in[4]; const float* wb = (const float*)d_in[5]; const float* bb = (const float*)d_in[6];
    const float* gnw = (const float*)d_in[7]; const float* w_out = (const float*)d_in[8]; const float* norm2_w = (const float*)d_in[9];
    const float* rgw = (const float*)d_in[10]; const float* rgb = (const float*)d_in[11]; const float* rew = (const float*)d_in[12]; const float* reb = (const float*)d_in[13];
    const float* ewg = (const float*)d_in[14]; const float* ewu = (const float*)d_in[15]; const float* ewd = (const float*)d_in[16]; const float* fnw = (const float*)d_in[17];
    unsigned char* ws = (unsigned char*)d_ws; float* out = (float*)d_out;
    bf16* U = (bf16*)(ws + WS_U); bf16* PROJ = (bf16*)(ws + WS_PROJ); float* ODIR = (float*)(ws + WS_PART); bf16* YBUF = (bf16*)(ws + WS_PROJ);
    unsigned* CNT = (unsigned*)(ws + WS_CTL) + CW_CNT; int* LIST = (int*)(ws + WS_LIST); float* WGT = (float*)(ws + WS_WGT);
    hipMemsetAsync(ws + WS_CTL, 0, 1 * MiB, stream);
    k_rms_bf16<<<T / 4, 256, 0, stream>>>(x, norm1_w, U);
    k_gemm_naive<0><<<dim3(PP / 64, T / 64), 256, 0, stream>>>(U, D, w_in, INW, D, PROJ, nullptr, nullptr);
    k_gla_naive<<<16, 128, 0, stream>>>(PROJ, wf, bfv, wb, bb, ODIR);
    k_gla_post<<<T * 4 / 4, 256, 0, stream>>>(ODIR, PROJ, gnw, U);
    k_attn_naive<<<T * 8 / 4, 256, 0, stream>>>(PROJ, U);
    k_gemm_naive<1><<<dim3(D / 64, T / 64), 256, 0, stream>>>(U, D, w_out, D, D, nullptr, out, x);
    k_router<<<T / 4, 256, 0, stream>>>(out, norm2_w, rgw, rgb, rew, reb, U, CNT, LIST, WGT);
    k_moe_naive<<<dim3(T / 8, 32), 256, 0, stream>>>(U, CNT, LIST, WGT, ewg, ewu, ewd, YBUF);
    k_final<<<T / 4, 256, 0, stream>>>(out, YBUF, fnw);
}
```

```cpp
#include <hip/hip_runtime.h>
#include <cstdio>
#include <cstdint>

typedef unsigned short bf16;
constexpr int T = 16384, SEQ = 8192, D = 1024;
constexpr int PP = 3328;
constexpr int C_GQ = 0, C_GK = 256, C_GV = 512, C_GG = 1024, C_AQ = 1536, C_AK = 2048, C_AV = 2560, C_LF = 3072, C_LB = 3088;
constexpr int INW = 3104;
constexpr size_t MiB = 1u << 20;
constexpr size_t WS_CTL = 0, WS_U = 10 * MiB, WS_PROJ = 42 * MiB, WS_KV = 146 * MiB, WS_PART = 178 * MiB, WS_YBUF = 186 * MiB,
                 WS_LIST = 250 * MiB, WS_WGT = 252 * MiB;
constexpr int CW_CNT = 1024;

__device__ __forceinline__ float bf2f(bf16 b) { return __uint_as_float(((unsigned)b) << 16); }
__device__ __forceinline__ bf16 f2bf(float f) { unsigned u = __float_as_uint(f); return (bf16)((u + 0x7fffu + ((u >> 16) & 1u)) >> 16); }
__device__ __forceinline__ float wave_sum(float v) {
#pragma unroll
    for (int o = 1; o < 64; o <<= 1) v += __shfl_xor(v, o);
    return v;
}

__global__ __launch_bounds__(256) void k_rms_bf16(const float* x, const float* w, bf16* out) {
    const int row = blockIdx.x * 4 + (threadIdx.x >> 6), lane = threadIdx.x & 63;
    const float4* xr = (const float4*)(x + (size_t)row * D) + lane;
    float4 v[4]; float s = 0.f;
#pragma unroll
    for (int j = 0; j < 4; ++j) { v[j] = xr[64 * j]; s += v[j].x * v[j].x + v[j].y * v[j].y + v[j].z * v[j].z + v[j].w * v[j].w; }
    const float rstd = rsqrtf(wave_sum(s) * (1.f / D) + 1e-6f);
#pragma unroll
    for (int j = 0; j < 4; ++j) {
        const float4 ww = ((const float4*)w)[lane + 64 * j];
        bf16* o = out + (size_t)row * D + (lane + 64 * j) * 4;
        o[0] = f2bf(v[j].x * rstd * ww.x); o[1] = f2bf(v[j].y * rstd * ww.y); o[2] = f2bf(v[j].z * rstd * ww.z); o[3] = f2bf(v[j].w * rstd * ww.w);
    }
}

template <int MODE>
__global__ __launch_bounds__(256) void k_gemm_naive(const bf16* A, int lda, const float* B, int ldb, int K, bf16* Cb, float* Cf, const float* res) {
    __shared__ float As[16][68];
    __shared__ float Bs[16][68];
    const int tx = threadIdx.x & 15, ty = threadIdx.x >> 4;
    const int m0 = blockIdx.y * 64, n0 = blockIdx.x * 64;
    float acc[4][4];
#pragma unroll
    for (int i = 0; i < 4; ++i)
#pragma unroll
        for (int j = 0; j < 4; ++j) acc[i][j] = 0.f;
    for (int k0 = 0; k0 < K; k0 += 16) {
#pragma unroll
        for (int i = 0; i < 4; ++i) { const int e = threadIdx.x + i * 256, r = e >> 4, kk = e & 15; As[kk][r] = bf2f(A[(size_t)(m0 + r) * lda + k0 + kk]); }
#pragma unroll
        for (int i = 0; i < 4; ++i) { const int e = threadIdx.x + i * 256, kk = e >> 6, c = e & 63; int n = n0 + c, oc;
            if (MODE == 0) oc = n < 1536 ? n : (n < 3072 ? n + 32 : (n < 3104 ? n - 1536 : -1)); else oc = n;
            Bs[kk][c] = oc >= 0 ? B[(size_t)(k0 + kk) * ldb + oc] : 0.f; }
        __syncthreads();
#pragma unroll
        for (int kk = 0; kk < 16; ++kk) {
            float a[4], b[4];
#pragma unroll
            for (int i = 0; i < 4; ++i) { a[i] = As[kk][ty * 4 + i]; b[i] = Bs[kk][tx * 4 + i]; }
#pragma unroll
            for (int i = 0; i < 4; ++i)
#pragma unroll
                for (int j = 0; j < 4; ++j) acc[i][j] += a[i] * b[j];
        }
        __syncthreads();
    }
#pragma unroll
    for (int i = 0; i < 4; ++i)
#pragma unroll
        for (int j = 0; j < 4; ++j) {
            const int m = m0 + ty * 4 + i, n = n0 + tx * 4 + j;
            if (MODE == 0) Cb[(size_t)m * PP + n] = f2bf(acc[i][j]);
            else Cf[(size_t)m * D + n] = res[(size_t)m * D + n] + acc[i][j];
        }
}

__device__ __forceinline__ float log_sigmoid(float x) { return fminf(x, 0.f) - log1pf(expf(-fabsf(x))); }
__global__ __launch_bounds__(128) void k_gla_naive(const bf16* proj, const float* wf, const float* bfv, const float* wb, const float* bb, float* o_dir) {
    const int combo = blockIdx.x, dir = combo & 1, h = (combo >> 1) & 3, b = combo >> 3;
    const int vc = threadIdx.x;
    const float* W = dir ? wb : wf; const float* Bv = dir ? bb : bfv;
    __shared__ float sa[16][64], sq[16][64], sk[16][64];
    float st[64];
#pragma unroll
    for (int d = 0; d < 64; ++d) st[d] = 0.f;
    float* outp = o_dir + (size_t)dir * T * 512;
    for (int s0 = 0; s0 < SEQ; s0 += 16) {
        __syncthreads();
        for (int e = threadIdx.x; e < 16 * 64; e += 128) {
            const int i = e >> 6, d = e & 63;
            const int pos = dir ? (SEQ - 1 - (s0 + i)) : (s0 + i);
            const size_t row = (size_t)(b * SEQ + pos) * PP;
            float z = Bv[h * 64 + d];
            for (int r = 0; r < 16; ++r) z += bf2f(proj[row + (dir ? C_LB : C_LF) + r]) * W[r * 256 + h * 64 + d];
            sa[i][d] = expf(log_sigmoid(z) * (1.f / 16.f));
            sq[i][d] = bf2f(proj[row + C_GQ + h * 64 + d]) * 0.125f;
            sk[i][d] = bf2f(proj[row + C_GK + h * 64 + d]);
        }
        __syncthreads();
        for (int i = 0; i < 16; ++i) {
            const int pos = dir ? (SEQ - 1 - (s0 + i)) : (s0 + i);
            const size_t tok = (size_t)(b * SEQ + pos);
            const float v = bf2f(proj[tok * PP + C_GV + h * 128 + vc]);
            float o = 0.f;
#pragma unroll
            for (int d = 0; d < 64; ++d) { st[d] = st[d] * sa[i][d] + sk[i][d] * v; o += sq[i][d] * st[d]; }
            outp[tok * 512 + h * 128 + vc] = o;
        }
    }
}
__global__ __launch_bounds__(256) void k_gla_post(const float* o_dir, const bf16* proj, const float* nw, bf16* mixed) {
    const int item = blockIdx.x * 4 + (threadIdx.x >> 6), lane = threadIdx.x & 63;
    const int tok = item >> 2, h = item & 3;
    const size_t off = (size_t)tok * 512 + h * 128;
    const float a0 = o_dir[off + lane] + o_dir[(size_t)T * 512 + off + lane], a1 = o_dir[off + 64 + lane] + o_dir[(size_t)T * 512 + off + 64 + lane];
    const float rstd = rsqrtf(wave_sum(a0 * a0 + a1 * a1) * (1.f / 128.f) + 1e-6f);
    const float g0 = bf2f(proj[(size_t)tok * PP + C_GG + h * 128 + lane]), g1 = bf2f(proj[(size_t)tok * PP + C_GG + h * 128 + 64 + lane]);
    mixed[(size_t)tok * D + h * 128 + lane] = f2bf(a0 * rstd * nw[lane] * (g0 / (1.f + expf(-g0))));
    mixed[(size_t)tok * D + h * 128 + 64 + lane] = f2bf(a1 * rstd * nw[64 + lane] * (g1 / (1.f + expf(-g1))));
}

__device__ __forceinline__ float rope_val(float x, int lane, int pos) {
    const float partner = __shfl_xor(x, 8);
    if (lane >= 16) return x;
    const int i = lane & 7;
    const float inv = (float)exp2(-(double)i * 0.125 * 18.931568569324174);
    const float ang = (float)pos * inv;
    const float c = cosf(ang), s = sinf(ang);
    return lane < 8 ? x * c - partner * s : x * c + partner * s;
}
__global__ __launch_bounds__(256) void k_attn_naive(const bf16* proj, bf16* mixed) {
    const int item = blockIdx.x * 4 + (threadIdx.x >> 6), lane = threadIdx.x & 63;
    const int tok = item >> 3, h = item & 7, b = tok / SEQ, s = tok % SEQ;
    const float q = rope_val(bf2f(proj[(size_t)tok * PP + C_AQ + h * 64 + lane]), lane, s) * 0.125f;
    float m = -1e30f, l = 0.f, o = 0.f;
    for (int p = 0; p < 3; ++p) {
        const int dil = p == 0 ? 1 : (p == 1 ? 4 : 16);
        for (int dl = -64; dl <= 64; ++dl) {
            const int ks = s + dil * dl;
            if (ks < 0 || ks >= SEQ) continue;
            const size_t kt = (size_t)(b * SEQ + ks);
            const float k = rope_val(bf2f(proj[kt * PP + C_AK + h * 64 + lane]), lane, ks);
            const float sc = wave_sum(q * k);
            const float mn = fmaxf(m, sc), al = expf(m - mn), pe = expf(sc - mn);
            l = l * al + pe; o = o * al + pe * bf2f(proj[kt * PP + C_AV + h * 64 + lane]); m = mn;
        }
    }
    mixed[(size_t)tok * D + 512 + h * 64 + lane] = f2bf(o / l);
}

__global__ __launch_bounds__(256) void k_router(const float* hbuf, const float* nw, const float* wg, const float* bg, const float* we, const float* be,
                                                bf16* u2, unsigned* cnt, int* list, float* wgt) {
    const int row = blockIdx.x * 4 + (threadIdx.x >> 6), lane = threadIdx.x & 63;
    const float4* xr = (const float4*)(hbuf + (size_t)row * D) + lane;
    float u[16]; float s = 0.f;
#pragma unroll
    for (int j = 0; j < 4; ++j) { const float4 v = xr[64 * j]; u[4 * j] = v.x; u[4 * j + 1] = v.y; u[4 * j + 2] = v.z; u[4 * j + 3] = v.w; s += v.x * v.x + v.y * v.y + v.z * v.z + v.w * v.w; }
    const float rstd = rsqrtf(wave_sum(s) * (1.f / D) + 1e-6f);
#pragma unroll
    for (int j = 0; j < 4; ++j) {
        const float4 ww = ((const float4*)nw)[lane + 64 * j];
        u[4 * j] *= rstd * ww.x; u[4 * j + 1] *= rstd * ww.y; u[4 * j + 2] *= rstd * ww.z; u[4 * j + 3] *= rstd * ww.w;
        bf16* o = u2 + (size_t)row * D + (lane + 64 * j) * 4;
#pragma unroll
        for (int c = 0; c < 4; ++c) o[c] = f2bf(u[4 * j + c]);
    }
    float gl[4];
#pragma unroll
    for (int g = 0; g < 4; ++g) { float p = 0.f;
#pragma unroll
        for (int j = 0; j < 4; ++j)
#pragma unroll
            for (int c = 0; c < 4; ++c) p += u[4 * j + c] * wg[(size_t)((lane + 64 * j) * 4 + c) * 4 + g];
        gl[g] = wave_sum(p) + bg[g]; }
    int gs = 0; float gm = gl[0];
#pragma unroll
    for (int g = 1; g < 4; ++g) if (gl[g] > gm) { gm = gl[g]; gs = g; }
    float gz = 0.f;
#pragma unroll
    for (int g = 0; g < 4; ++g) gz += expf(gl[g] - gm);
    const float gw = 1.f / gz;
    float el[8];
#pragma unroll
    for (int e = 0; e < 8; ++e) { float p = 0.f;
#pragma unroll
        for (int j = 0; j < 4; ++j)
#pragma unroll
            for (int c = 0; c < 4; ++c) p += u[4 * j + c] * we[((size_t)gs * D + (lane + 64 * j) * 4 + c) * 8 + e];
        el[e] = wave_sum(p) + be[gs * 8 + e]; }
    int i0 = 0; float v0 = el[0];
#pragma unroll
    for (int e = 1; e < 8; ++e) if (el[e] > v0) { v0 = el[e]; i0 = e; }
    int i1 = -1; float v1 = -3.0e38f;
#pragma unroll
    for (int e = 0; e < 8; ++e) if (e != i0 && el[e] > v1) { v1 = el[e]; i1 = e; }
    const float e1 = expf(v1 - v0), w0 = gw / (1.f + e1), w1 = gw * e1 / (1.f + e1);
    if (lane == 0) {
        const int ex0 = gs * 8 + i0, ex1 = gs * 8 + i1;
        const unsigned s0 = atomicAdd(cnt + ex0, 1u), s1 = atomicAdd(cnt + ex1, 1u);
        list[(size_t)ex0 * T + s0] = row * 2; list[(size_t)ex1 * T + s1] = row * 2 + 1;
        wgt[row * 2] = w0; wgt[row * 2 + 1] = w1;
    }
}

__global__ __launch_bounds__(256) void k_moe_naive(const bf16* u2, const unsigned* cnt, const int* list, const float* wgt,
                                                   const float* Wg, const float* Wu, const float* Wd, bf16* ybuf) {
    const int e = blockIdx.y, r0 = blockIdx.x * 8;
    const int n = (int)cnt[e];
    if (r0 >= n) return;
    __shared__ float X[8][1024];
    __shared__ float Aact[8][512];
    __shared__ int asg[8];
    if (threadIdx.x < 8) asg[threadIdx.x] = (r0 + threadIdx.x < n) ? list[(size_t)e * T + r0 + threadIdx.x] : -1;
    __syncthreads();
    for (int i = threadIdx.x; i < 8 * 1024; i += 256) { const int r = i >> 10, k = i & 1023; X[r][k] = asg[r] >= 0 ? bf2f(u2[(size_t)(asg[r] >> 1) * D + k]) : 0.f; }
    __syncthreads();
    const float* wg = Wg + (size_t)e * 1024 * 512; const float* wu = Wu + (size_t)e * 1024 * 512; const float* wd = Wd + (size_t)e * 512 * 1024;
    for (int cc = 0; cc < 2; ++cc) {
        const int c = threadIdx.x + 256 * cc;
        float g[8], u[8];
#pragma unroll
        for (int r = 0; r < 8; ++r) { g[r] = 0.f; u[r] = 0.f; }
        for (int k = 0; k < 1024; ++k) { const float a = wg[(size_t)k * 512 + c], bq = wu[(size_t)k * 512 + c];
#pragma unroll
            for (int r = 0; r < 8; ++r) { g[r] += X[r][k] * a; u[r] += X[r][k] * bq; } }
#pragma unroll
        for (int r = 0; r < 8; ++r) Aact[r][c] = bf2f(f2bf(g[r] / (1.f + expf(-g[r])) * u[r]));
    }
    __syncthreads();
    for (int cc = 0; cc < 4; ++cc) {
        const int c = threadIdx.x + 256 * cc;
        float y[8];
#pragma unroll
        for (int r = 0; r < 8; ++r) y[r] = 0.f;
        for (int k = 0; k < 512; ++k) { const float a = wd[(size_t)k * 1024 + c];
#pragma unroll
            for (int r = 0; r < 8; ++r) y[r] += Aact[r][k] * a; }
#pragma unroll
        for (int r = 0; r < 8; ++r) if (asg[r] >= 0) ybuf[(size_t)asg[r] * D + c] = f2bf(y[r] * wgt[asg[r]]);
    }
}

__global__ __launch_bounds__(256) void k_final(float* hbuf, const bf16* ybuf, const float* w) {
    const int row = blockIdx.x * 4 + (threadIdx.x >> 6), lane = threadIdx.x & 63;
    float4* xr = (float4*)(hbuf + (size_t)row * D) + lane;
    float u[16]; float s = 0.f;
#pragma unroll
    for (int j = 0; j < 4; ++j) { const float4 v = xr[64 * j]; u[4 * j] = v.x; u[4 * j + 1] = v.y; u[4 * j + 2] = v.z; u[4 * j + 3] = v.w; }
#pragma unroll
    for (int j = 0; j < 4; ++j)
#pragma unroll
        for (int c = 0; c < 4; ++c) {
            const size_t col = (size_t)(lane + 64 * j) * 4 + c;
            u[4 * j + c] += bf2f(ybuf[(size_t)(row * 2) * D + col]) + bf2f(ybuf[(size_t)(row * 2 + 1) * D + col]);
            s += u[4 * j + c] * u[4 * j + c];
        }
    const float rstd = rsqrtf(wave_sum(s) * (1.f / D) + 1e-6f);
#pragma unroll
    for (int j = 0; j < 4; ++j) { const float4 ww = ((const float4*)w)[lane + 64 * j];
        xr[64 * j] = make_float4(u[4 * j] * rstd * ww.x, u[4 * j + 1] * rstd * ww.y, u[4 * j + 2] * rstd * ww.z, u[4 * j + 3] * rstd * ww.w); }
}


namespace pg8 {
#define PG8_LAS __attribute__((address_space(3)))
typedef unsigned short bf16_t;
typedef short bf16x8 __attribute__((ext_vector_type(8)));
typedef float f32x4 __attribute__((ext_vector_type(4)));
typedef unsigned u32x4 __attribute__((ext_vector_type(4)));
constexpr int BM = 256, BK = 64, HALF = 128, HTB = HALF * BK * 2  , STAGE_BYTES = 8 * HTB, NXCD = 8, WGM = 8;

__host__ __device__ __forceinline__ int lds_byte(int r, int c) { const int st = (r >> 4) * 2 + (c >> 5), rr = r & 15, cc = c & 31, ob = rr * 64 + cc * 2; return st * 1024 + (ob ^ (((ob >> 9) & 1) << 5)); }
__host__ __device__ __forceinline__ void stage_rc(int b, int& R, int& C) { const int st = b / 1024, sb = b % 1024, swz = sb ^ (((sb >> 9) & 1) << 5); R = (st >> 1) * 16 + swz / 64; C = (st & 1) * 32 + (swz % 64) / 2; }
__host__ __device__ __forceinline__ int perm32(int rho) { const int n = rho >> 4, i = rho & 15; return 8 * (i >> 2) + 4 * n + (i & 3); }

struct Unit { int pm, pn, aux; };

struct StaticOrder {
    const char* A; const char* Bt; int K, nM, nN, nwg, G, c;
    __device__ void init(const void* A_, const void* Bt_, int M, int N, int K_, int G_, int c_) { A = (const char*)A_; Bt = (const char*)Bt_; K = K_; nM = M / BM; nN = N / BM; nwg = nM * nN; G = G_; c = c_; }
    __device__ bool next(int i, Unit& u) const {
        const long L = (long)i * G + c; if (L >= nwg) return false;
        int wgid = (int)L; { const int q = nwg / NXCD, r = nwg % NXCD, xcd = wgid % NXCD, off = wgid / NXCD; wgid = (xcd < r ? xcd * (q + 1) : r * (q + 1) + (xcd - r) * q) + off; }
        const int nig = WGM * nN, gid = wgid / nig, fm = gid * WGM, gsz = (nM - fm) < WGM ? (nM - fm) : WGM;
        u.pm = fm + ((wgid % nig) % gsz); u.pn = (wgid % nig) / gsz; u.aux = 0; return true;
    }
    __device__ __forceinline__ const char* a_base(const Unit& u) const { return A + (size_t)u.pm * BM * K * 2; }
    __device__ __forceinline__ const char* b_base(const Unit& u) const { return Bt + (size_t)u.pn * BM * K * 2; }
    __device__ __forceinline__ unsigned a_off(const Unit&, int r) const { return (unsigned)(r * K * 2); }
};
template <bool GATHER> struct MoeOrder {
    const char* A; const char* Bt; size_t estride; int K, total, G, c; const PG8_LAS int* tab; const unsigned* cnt; const int* list;
    __device__ bool next(int i, Unit& u) const {
        const long L = (long)i * G + c; if (L >= total) return false;
        int id = (int)L; { const int q = total / NXCD, r = total % NXCD, xcd = id % NXCD, off = id / NXCD; id = (xcd < r ? xcd * (q + 1) : r * (q + 1) + (xcd - r) * q) + off; }
        u.pm = id >> 2; u.pn = id & 3; u.aux = tab[u.pm]; return true;
    }
    __device__ __forceinline__ const char* a_base(const Unit& u) const { return GATHER ? A : A + (size_t)u.pm * BM * K * 2; }
    __device__ __forceinline__ const char* b_base(const Unit& u) const { return Bt + (size_t)(u.aux >> 8) * estride + (size_t)u.pn * BM * K * 2; }
    __device__ __forceinline__ unsigned a_off(const Unit& u, int r) const {
        if (!GATHER) return (unsigned)(r * K * 2);
        const int e = u.aux >> 8, idx = (u.aux & 255) * 256 + r; const int n = (int)cnt[e];
        const int tok = idx < n ? (list[(size_t)e * 16384 + idx] >> 1) : 0;
        return (unsigned)tok * (unsigned)(K * 2);
    }
};

__device__ __forceinline__ unsigned cvt_pk_bf16(float lo, float hi) { unsigned r; asm volatile("v_cvt_pk_bf16_f32 %0, %1, %2" : "=v"(r) : "v"(lo), "v"(hi)); return r; }

struct EpiBf16 {
    static constexpr bool PERM = true, AFTER_DRAIN = false;
    bf16_t* O; int ldc;
    __device__ __forceinline__ void operator()(const f32x4 (&acc)[2][2][4][2], const Unit& u, int wr, int wc, int fr, int fq) const {
        const int row0 = u.pm * BM + wr * 64 + fr, col0 = u.pn * BM + wc * 32 + 8 * fq;
#pragma unroll
        for (int ai = 0; ai < 2; ++ai)
#pragma unroll
            for (int m = 0; m < 4; ++m) { bf16_t* rowp = O + (size_t)(row0 + ai * HALF + m * 16) * ldc + col0;
#pragma unroll
                for (int bj = 0; bj < 2; ++bj) { const f32x4 v0 = acc[ai][bj][m][0], v1 = acc[ai][bj][m][1];
                    u32x4 w; w.x = cvt_pk_bf16(v0[0], v0[1]); w.y = cvt_pk_bf16(v0[2], v0[3]); w.z = cvt_pk_bf16(v1[0], v1[1]); w.w = cvt_pk_bf16(v1[2], v1[3]);
                    *(u32x4*)(rowp + bj * HALF) = w; } }
    }
};
struct EpiF32Res {
    static constexpr bool PERM = false, AFTER_DRAIN = false;
    float* C; const float* res; int ldc;
    __device__ __forceinline__ void operator()(const f32x4 (&acc)[2][2][4][2], const Unit& u, int wr, int wc, int fr, int fq) const {
        const int row0 = u.pm * BM + wr * 64 + fr, col0 = u.pn * BM + wc * 32 + 4 * fq;
#pragma unroll
        for (int ai = 0; ai < 2; ++ai) { f32x4 rv[4][2][2];
#pragma unroll
            for (int m = 0; m < 4; ++m) { const size_t off = (size_t)(row0 + ai * HALF + m * 16) * ldc + col0;
#pragma unroll
                for (int bj = 0; bj < 2; ++bj)
#pragma unroll
                    for (int n = 0; n < 2; ++n) rv[m][bj][n] = __builtin_nontemporal_load((const f32x4*)(res + off + bj * HALF + n * 16)); }
#pragma unroll
            for (int m = 0; m < 4; ++m) { const size_t off = (size_t)(row0 + ai * HALF + m * 16) * ldc + col0;
#pragma unroll
                for (int bj = 0; bj < 2; ++bj)
#pragma unroll
                    for (int n = 0; n < 2; ++n) *(f32x4*)(C + off + bj * HALF + n * 16) = rv[m][bj][n] + acc[ai][bj][m][n]; }
            asm volatile("" ::: "memory"); }
    }
};
__device__ __forceinline__ float silu_mul(float g, float u) { return g * u * __builtin_amdgcn_rcpf(1.0f + __builtin_amdgcn_exp2f(-1.4426950408889634f * g)); }
struct EpiGateUp {
    static constexpr bool PERM = true, AFTER_DRAIN = false;
    bf16_t* ACT;
    __device__ __forceinline__ void operator()(const f32x4 (&acc)[2][2][4][2], const Unit& u, int wr, int wc, int fr, int fq) const {
        const int row0 = u.pm * BM + wr * 64 + fr, col0 = u.pn * HALF + wc * 32 + 8 * fq;
#pragma unroll
        for (int ai = 0; ai < 2; ++ai)
#pragma unroll
            for (int m = 0; m < 4; ++m) { bf16_t* rowp = ACT + (size_t)(row0 + ai * HALF + m * 16) * 512 + col0;
                const f32x4 g0 = acc[ai][0][m][0], g1 = acc[ai][0][m][1], u0 = acc[ai][1][m][0], u1 = acc[ai][1][m][1];
                u32x4 w; w.x = cvt_pk_bf16(silu_mul(g0[0], u0[0]), silu_mul(g0[1], u0[1])); w.y = cvt_pk_bf16(silu_mul(g0[2], u0[2]), silu_mul(g0[3], u0[3]));
                w.z = cvt_pk_bf16(silu_mul(g1[0], u1[0]), silu_mul(g1[1], u1[1])); w.w = cvt_pk_bf16(silu_mul(g1[2], u1[2]), silu_mul(g1[3], u1[3]));
                *(u32x4*)rowp = w; }
    }
};
struct EpiDown {
    static constexpr bool PERM = true, AFTER_DRAIN = false;
    bf16_t* Y; const int* list; const unsigned* cnt; const float* wgt;
    __device__ __forceinline__ void operator()(const f32x4 (&acc)[2][2][4][2], const Unit& u, int wr, int wc, int fr, int fq) const {
        const int e = u.aux >> 8, rt = u.aux & 255, n = (int)cnt[e];
        const int r0 = rt * BM + wr * 64 + fr, col0 = u.pn * BM + wc * 32 + 8 * fq;
#pragma unroll
        for (int ai = 0; ai < 2; ++ai)
#pragma unroll
            for (int m = 0; m < 4; ++m) { const int r = r0 + ai * HALF + m * 16;
                if (r < n) { const int a = list[(size_t)e * 16384 + r]; const float w = wgt[a]; bf16_t* rowp = Y + (size_t)a * 1024 + col0;
#pragma unroll
                    for (int bj = 0; bj < 2; ++bj) { const f32x4 v0 = acc[ai][bj][m][0] * w, v1 = acc[ai][bj][m][1] * w;
                        u32x4 o; o.x = cvt_pk_bf16(v0[0], v0[1]); o.y = cvt_pk_bf16(v0[2], v0[3]); o.z = cvt_pk_bf16(v1[0], v1[1]); o.w = cvt_pk_bf16(v1[2], v1[3]);
                        *(u32x4*)(rowp + bj * HALF) = o; } } }
    }
};

template <class Epi, class Sched, bool GATHER, bool ALIGN_EPI>
__device__ __forceinline__ void gemm_phase(PG8_LAS unsigned char* lds, const int K, const Sched& S, const Epi& E) {
    const int tid = threadIdx.x, wid = __builtin_amdgcn_readfirstlane(tid >> 6), lane = tid & 63, wr = wid >> 2, wc = wid & 3, fr = lane & 15, fq = lane >> 4;
    const int nt = K / BK;
    int RA[2], CA[2]; unsigned voffB[2];
#pragma unroll
    for (int i = 0; i < 2; ++i) { int R, C; stage_rc(tid * 16 + i * 8192, R, C); const int Rb = Epi::PERM ? ((R & ~31) + perm32(R & 31)) : R;
        RA[i] = R; CA[i] = C * 2; voffB[i] = (unsigned)(Rb * K + C) * 2u; }
    const size_t kstep = (size_t)(BK * 2);
    const size_t hstep = (size_t)HALF * K * 2;
    const unsigned ldsw = (unsigned)wid * 1024u;
    const int aoff = lds_byte(wr * 64 + fr, fq * 8), boff = lds_byte(wc * 32 + fr, fq * 8);
#define PG8_SA(b, h) (((b) * 2 + (h)) * HTB)
#define PG8_SB(b, h) ((4 + (b) * 2 + (h)) * HTB)
#define PG8_STAGE(bufoff, gbase, voff) do { _Pragma("unroll") for (int _i = 0; _i < 2; ++_i) \
        __builtin_amdgcn_global_load_lds((const unsigned*)((const char*)(gbase) + (voff)[_i]), (PG8_LAS unsigned*)(lds + (bufoff) + ldsw + _i * 8192), 16, 0, 0); } while (0)
#define PG8_LDA(dst, b, h) do { _Pragma("unroll") for (int m = 0; m < 4; ++m) _Pragma("unroll") for (int k = 0; k < 2; ++k) dst[m][k] = *(const PG8_LAS bf16x8*)(lds + PG8_SA(b, h) + aoff + m * 2048 + k * 1024); } while (0)
#define PG8_LDB(dst, b, h) do { _Pragma("unroll") for (int n = 0; n < 2; ++n) _Pragma("unroll") for (int k = 0; k < 2; ++k) dst[n][k] = *(const PG8_LAS bf16x8*)(lds + PG8_SB(b, h) + boff + n * 2048 + k * 1024); } while (0)
#define PG8_MMA(ai, bj, At, Bt) do { __builtin_amdgcn_s_setprio(1); _Pragma("unroll") for (int m = 0; m < 4; ++m) _Pragma("unroll") for (int n = 0; n < 2; ++n) _Pragma("unroll") for (int k = 0; k < 2; ++k) \
        acc[ai][bj][m][n] = __builtin_amdgcn_mfma_f32_16x16x32_bf16(Bt[n][k], At[m][k], acc[ai][bj][m][n], 0, 0, 0); __builtin_amdgcn_s_setprio(0); } while (0)
#define PG8_WAIT_V(n) asm volatile("s_waitcnt vmcnt(" #n ")" ::: "memory")
#define PG8_WAIT_L(n) asm volatile("s_waitcnt lgkmcnt(" #n ")" ::: "memory")
#define PG8_BAR __builtin_amdgcn_s_barrier()
#define PG8_SCHED __builtin_amdgcn_sched_barrier(0)
#define PG8_AOFFS(dst, u) do { _Pragma("unroll") for (int _h = 0; _h < 2; ++_h) _Pragma("unroll") for (int _i = 0; _i < 2; ++_i) dst[_h][_i] = S.a_off(u, RA[_i] + HALF * _h) + (unsigned)CA[_i]; } while (0)
    Unit cur, nxt; int ui = 0;
    if (!S.next(0, cur)) return;
    f32x4 acc[2][2][4][2];
#pragma unroll
    for (int a = 0; a < 2; ++a)
#pragma unroll
        for (int b = 0; b < 2; ++b)
#pragma unroll
            for (int m = 0; m < 4; ++m)
#pragma unroll
                for (int n = 0; n < 2; ++n) acc[a][b][m][n] = (f32x4){0.f, 0.f, 0.f, 0.f};
    bf16x8 At[4][2], B0[2][2], B1[2][2];
    unsigned vA[2][2], vN[2][2];
    PG8_AOFFS(vA, cur);
    const char* cA = S.a_base(cur); const char* cB = S.b_base(cur);
    PG8_STAGE(PG8_SB(0, 0), cB, voffB); PG8_STAGE(PG8_SB(0, 1), cB + hstep, voffB); PG8_STAGE(PG8_SA(0, 0), cA, vA[0]); PG8_STAGE(PG8_SA(0, 1), cA, vA[1]);
    if (wr == 1) PG8_BAR;
    PG8_WAIT_V(2); PG8_BAR;
    PG8_STAGE(PG8_SB(1, 0), cB + kstep, voffB); PG8_STAGE(PG8_SA(1, 0), cA + kstep, vA[0]); PG8_STAGE(PG8_SB(1, 1), cB + hstep + kstep, voffB);
    PG8_WAIT_V(6); PG8_BAR;
    for (;;) {
        const bool has_next = S.next(ui + 1, nxt);
        const char* nA = cA; const char* nB = cB;
        if (has_next) { nA = S.a_base(nxt); nB = S.b_base(nxt); }
        if (GATHER) { if (has_next) { PG8_AOFFS(vN, nxt); } else {
#pragma unroll
            for (int h = 0; h < 2; ++h)
#pragma unroll
                for (int i = 0; i < 2; ++i) vN[h][i] = vA[h][i]; } }
        for (int t = 0; t < nt; t += 2) {
            const bool last = (t == nt - 2);
            const char* a1 = cA + (size_t)(t + 1) * kstep;
            const char* a2 = last ? nA : cA + (size_t)(t + 2) * kstep; const char* b2 = last ? nB : cB + (size_t)(t + 2) * kstep;
            const char* a3 = a2 + kstep; const char* b3 = b2 + kstep;
            unsigned vS[2][2];
#pragma unroll
            for (int h = 0; h < 2; ++h)
#pragma unroll
                for (int i = 0; i < 2; ++i) vS[h][i] = (GATHER && last) ? vN[h][i] : vA[h][i];
            PG8_LDB(B0, 0, 0); PG8_LDB(B1, 0, 1); PG8_SCHED; PG8_LDA(At, 0, 0); PG8_STAGE(PG8_SA(1, 1), a1, vA[1]);
            PG8_WAIT_V(8); PG8_WAIT_L(0); PG8_BAR; PG8_MMA(0, 0, At, B0); PG8_MMA(0, 1, At, B1); PG8_BAR; PG8_SCHED;
            PG8_LDA(At, 0, 1); PG8_STAGE(PG8_SB(0, 0), b2, voffB); PG8_STAGE(PG8_SB(0, 1), b2 + hstep, voffB); PG8_STAGE(PG8_SA(0, 0), a2, vS[0]);
            PG8_WAIT_V(8); PG8_WAIT_L(0); PG8_BAR; PG8_MMA(1, 0, At, B0); PG8_MMA(1, 1, At, B1); PG8_BAR; PG8_SCHED;
            PG8_LDB(B0, 1, 0); PG8_LDB(B1, 1, 1); PG8_SCHED; PG8_LDA(At, 1, 0); PG8_STAGE(PG8_SA(0, 1), a2, vS[1]);
            PG8_WAIT_V(8); PG8_WAIT_L(0); PG8_BAR; PG8_MMA(0, 0, At, B0); PG8_MMA(0, 1, At, B1); PG8_BAR; PG8_SCHED;
            PG8_LDA(At, 1, 1); PG8_STAGE(PG8_SB(1, 0), b3, voffB); PG8_STAGE(PG8_SB(1, 1), b3 + hstep, voffB); PG8_STAGE(PG8_SA(1, 0), a3, vS[0]);
            PG8_WAIT_V(8); PG8_WAIT_L(0); PG8_BAR; PG8_MMA(1, 0, At, B0); PG8_MMA(1, 1, At, B1); PG8_BAR; PG8_SCHED;
        }
        if constexpr (ALIGN_EPI) { if (wr == 0) PG8_BAR; }
        E(acc, cur, wr, wc, fr, fq);
        if (!has_next) break;
#pragma unroll
        for (int a = 0; a < 2; ++a)
#pragma unroll
            for (int b = 0; b < 2; ++b)
#pragma unroll
                for (int m = 0; m < 4; ++m)
#pragma unroll
                    for (int n = 0; n < 2; ++n) acc[a][b][m][n] = (f32x4){0.f, 0.f, 0.f, 0.f};
        cur = nxt; cA = nA; cB = nB; ++ui;
        if (GATHER) {
#pragma unroll
            for (int h = 0; h < 2; ++h)
#pragma unroll
                for (int i = 0; i < 2; ++i) vA[h][i] = vN[h][i]; }
        if constexpr (ALIGN_EPI) { if (wr == 1) PG8_BAR; }
    }
    PG8_WAIT_V(0);
    if constexpr (!ALIGN_EPI) { if (wr == 0) PG8_BAR; }
    PG8_BAR;
#undef PG8_SA
#undef PG8_SB
#undef PG8_STAGE
#undef PG8_LDA
#undef PG8_LDB
#undef PG8_MMA
#undef PG8_WAIT_V
#undef PG8_WAIT_L
#undef PG8_BAR
#undef PG8_SCHED
#undef PG8_AOFFS
}
}

constexpr int NWAVES = 8;
constexpr size_t WS_WIN = 1 * MiB;
constexpr size_t WS_WOUT = 8 * MiB;
constexpr size_t WS_WGU = 42 * MiB;
constexpr size_t WS_WD = 106 * MiB;
constexpr size_t WS_ACT = 146 * MiB;
constexpr size_t WS_ROPE = 253 * MiB;
constexpr size_t WS_DEC = 254 * MiB;
constexpr int CW_BAR = 4096;
constexpr int RING_OFF = 0, RING_BYTES = 131072;
constexpr int TAB_OFF = 147456, MISC_OFF = TAB_OFF + 1024, LDS_BYTES = MISC_OFF + 256;

#define GAS __attribute__((address_space(1)))
#define LAS __attribute__((address_space(3)))
typedef unsigned v4u __attribute__((ext_vector_type(4)));
typedef unsigned v2u __attribute__((ext_vector_type(2)));
typedef float f32x4 __attribute__((ext_vector_type(4)));
typedef short bf16x8 __attribute__((ext_vector_type(8)));
typedef GAS unsigned gu32;
#define RLX_AGENT __ATOMIC_RELAXED, __HIP_MEMORY_SCOPE_AGENT
#define LDS_WAIT() asm volatile("s_waitcnt lgkmcnt(0)" ::: "memory")
#define VM_WAIT() asm volatile("s_waitcnt vmcnt(0)" ::: "memory")
__device__ __forceinline__ unsigned pk2(float lo, float hi) { return (unsigned)f2bf(lo) | ((unsigned)f2bf(hi) << 16); }

#define XB_TMO      128
#define XB_XCNT(j)  (256  + 64 * (j))
#define XB_XSUB(j)  (1280 + 64 * (j))
#define XB_XGEN(j)  (2304 + 64 * (j))
#define XB_TOP      3328
#define XB_TOPGEN   3392
#define XCD_BAR_WORDS 3456
#define XB_SPIN_CAP (1u << 18)

__device__ __forceinline__ unsigned xb_ld(unsigned* p)              { return __hip_atomic_load(p, __ATOMIC_RELAXED, __HIP_MEMORY_SCOPE_AGENT); }
__device__ __forceinline__ unsigned xb_add(unsigned* p, unsigned v) { return __hip_atomic_fetch_add(p, v, __ATOMIC_RELAXED, __HIP_MEMORY_SCOPE_AGENT); }
__device__ __forceinline__ unsigned xb_xcc_id() { return (unsigned)__builtin_amdgcn_s_getreg((3 << 11) | 20) & 0xFu; }
#define XB_SPIN(cond, bar) do { unsigned _sp = 0; while (cond) { __builtin_amdgcn_s_sleep(1); \
    if ((++_sp & 255u) == 0u) { if (xb_ld(&(bar)[XB_TMO])) break; if (_sp > XB_SPIN_CAP) { atomicAdd(&(bar)[XB_TMO], 1u); break; } } } } while (0)

struct XcdBarrier {
    unsigned* bar; unsigned x;
    volatile LAS unsigned* st;
};
__device__ __forceinline__ XcdBarrier xcd_barrier_post(unsigned* bar, volatile LAS unsigned* st) {
    XcdBarrier b; b.bar = bar; b.x = xb_xcc_id(); b.st = st;
    if (threadIdx.x == 0) (void)xb_add(&bar[XB_XCNT(b.x)], 1u);
    return b;
}
__device__ __forceinline__ void xcd_barrier_complete(unsigned* bar, unsigned x, unsigned& nloc, unsigned& nx) {
    const unsigned G = gridDim.x * gridDim.y * gridDim.z;
    unsigned sum, cnt, mine, sp = 0u;
    for (;;) {
        sum = 0u; cnt = 0u; mine = 0u;
#pragma unroll
        for (unsigned j = 0; j < 16; ++j) { const unsigned c = xb_ld(&bar[XB_XCNT(j)]); sum += c; cnt += (c > 0u) ? 1u : 0u; mine = (j == x) ? c : mine; }
        if (sum == G) break;
        __builtin_amdgcn_s_sleep(1);
        if ((++sp & 255u) == 0u) { if (xb_ld(&bar[XB_TMO])) break; if (sp > XB_SPIN_CAP) { atomicAdd(&bar[XB_TMO], 1u); break; } }
    }
    nloc = mine > 0u ? mine : 1u; nx = cnt > 0u ? cnt : 1u;
}
__device__ __forceinline__ void xcd_barrier(const XcdBarrier& b) {
    asm volatile("s_waitcnt vmcnt(0)" ::: "memory");
    __syncthreads();
    if (threadIdx.x == 0) {
        unsigned* bar = b.bar;
        __builtin_amdgcn_s_waitcnt(0);
        unsigned nloc = b.st[0], nx = b.st[1];
        if (nloc == 0u) { xcd_barrier_complete(bar, b.x, nloc, nx); b.st[0] = nloc; b.st[1] = nx; }
        const unsigned old = xb_add(&bar[XB_XSUB(b.x)], 1u);
        const unsigned gen = old / nloc;
        if (old + 1u == (gen + 1u) * nloc) {
            __builtin_amdgcn_fence(__ATOMIC_RELEASE, "agent");
            asm volatile("s_waitcnt vmcnt(0)" ::: "memory");
            const unsigned og = xb_add(&bar[XB_TOP], 1u);
            const unsigned tg = og / nx;
            if (og + 1u == (tg + 1u) * nx) xb_add(&bar[XB_TOPGEN], 1u);
            else XB_SPIN(xb_ld(&bar[XB_TOPGEN]) == tg, bar);
            __builtin_amdgcn_fence(__ATOMIC_ACQUIRE, "agent");
            xb_add(&bar[XB_XGEN(b.x)], 1u);
            asm volatile("s_waitcnt vmcnt(0)" ::: "memory");
        } else {
            XB_SPIN(xb_ld(&bar[XB_XGEN(b.x)]) == gen, bar);
            __builtin_amdgcn_fence(__ATOMIC_ACQUIRE, "agent");
            asm volatile("s_waitcnt vmcnt(0)" ::: "memory");
        }
    }
    __syncthreads();
}

struct Frame {
    LAS unsigned char* lds;
    volatile LAS unsigned* MISC;
    gu32* ctl;
    int tid, lane, wave;
    int vcu, G;
    const float* in[18]; float* out; unsigned char* ws;
};

__device__ __forceinline__ void transpose_item(const float* W, int ldw, int k0, int n0, bf16* WT, int ldt, int row0, LAS float* scr, int lane) {
#pragma unroll 8
    for (int i = 0; i < 32; ++i) { const int kk = 2 * i + (lane >> 5); scr[kk * 33 + (lane & 31)] = W[(size_t)(k0 + kk) * ldw + n0 + (lane & 31)]; }
    LDS_WAIT(); asm volatile("" ::: "memory");
    const int c = lane & 7;
#pragma unroll
    for (int j = 0; j < 4; ++j) { const int n = (lane >> 3) + 8 * j; const LAS float* s = scr + (8 * c) * 33 + n;
        v4u o; o.x = pk2(s[0 * 33], s[1 * 33]); o.y = pk2(s[2 * 33], s[3 * 33]); o.z = pk2(s[4 * 33], s[5 * 33]); o.w = pk2(s[6 * 33], s[7 * 33]);
        *(GAS v4u*)(WT + (size_t)(row0 + n) * ldt + k0 + 8 * c) = o; }
    LDS_WAIT(); asm volatile("" ::: "memory");
}
__device__ __forceinline__ void rms_row_to_bf16(const float* xrow, const float* w, bf16* orow, int lane) {
    const GAS f32x4* xr = (const GAS f32x4*)xrow + lane;
    f32x4 v[4]; float s = 0.f;
#pragma unroll
    for (int j = 0; j < 4; ++j) { v[j] = xr[64 * j]; s += (v[j].x * v[j].x + v[j].y * v[j].y) + (v[j].z * v[j].z + v[j].w * v[j].w); }
    const float rstd = rsqrtf(wave_sum(s) * (1.f / D) + 1e-6f);
    GAS v2u* o8 = (GAS v2u*)orow + lane;
#pragma unroll
    for (int j = 0; j < 4; ++j) { const f32x4 ww = ((const GAS f32x4*)w)[lane + 64 * j]; v2u o; o.x = pk2(v[j].x * rstd * ww.x, v[j].y * rstd * ww.y); o.y = pk2(v[j].z * rstd * ww.z, v[j].w * rstd * ww.w); o8[64 * j] = o; }
}

__device__ __forceinline__ void p0_prologue(Frame& F) {
    LAS float* scr = (LAS float*)(F.lds + RING_OFF + F.wave * 16384);
    const int gw = F.vcu * NWAVES + F.wave, NGW = F.G * NWAVES;
    bf16* WIN = (bf16*)(F.ws + WS_WIN); bf16* WOUT = (bf16*)(F.ws + WS_WOUT);
    constexpr int I_IN = 16 * 97, I_OUT = 16 * 32;
    for (int it = gw; it < I_IN + I_OUT; it += NGW) {
        if (it < I_IN) { const int kb = it / 97, nb = it % 97; const int n0 = nb * 32;
            const int src = n0 < 1536 ? n0 : (n0 < 3072 ? n0 + 32 : n0 - 1536);
            transpose_item(F.in[2], INW, kb * 64, src, WIN, D, n0, scr, F.lane); }
        else { const int r = it - I_IN, kb = r / 32, nb = r % 32; transpose_item(F.in[8], D, kb * 64, nb * 32, WOUT, D, nb * 32, scr, F.lane); }
    }
    { GAS v4u* z = (GAS v4u*)(WIN + (size_t)INW * D); const int n16 = (PP - INW) * D * 2 / 16;
      for (int i = blockIdx.x * 512 + F.tid; i < n16; i += F.G * 512) z[i] = (v4u){0u, 0u, 0u, 0u}; }
    { float* rope = (float*)(F.ws + WS_ROPE);
      for (int i = blockIdx.x * 512 + F.tid; i < SEQ * 8; i += F.G * 512) { const int pos = i >> 3, j = i & 7;
          const double inv = exp2(-(double)j * 0.125 * 18.931568569324174);
          double r = (double)pos * inv * 0.15915494309189535; r -= floor(r);
          const float a = (float)(r * 6.283185307179586);
          rope[pos * 16 + j] = cosf(a); rope[pos * 16 + 8 + j] = sinf(a); } }
    bf16* U = (bf16*)(F.ws + WS_U);
    for (int m = gw; m < T; m += NGW) rms_row_to_bf16(F.in[0] + (size_t)m * D, F.in[1], U + (size_t)m * D, F.lane);
}

__device__ __forceinline__ void p6_router(Frame& F) {
    LAS float* WGs = (LAS float*)(F.lds);
    LAS float* WEs = (LAS float*)(F.lds + 16384);
    for (int i = F.tid; i < 1024; i += 512) ((LAS f32x4*)WGs)[i] = ((const GAS f32x4*)F.in[10])[i];
    for (int i = F.tid; i < 8192; i += 512) ((LAS f32x4*)WEs)[i] = ((const GAS f32x4*)F.in[12])[i];
    __syncthreads();
    const int gw = F.vcu * NWAVES + F.wave, NGW = F.G * NWAVES, lane = F.lane;
    bf16* U = (bf16*)(F.ws + WS_U); unsigned* CNT = (unsigned*)(F.ctl + CW_CNT); int* LIST = (int*)(F.ws + WS_LIST); float* WGT = (float*)(F.ws + WS_WGT);
    const float* nw = F.in[9]; const float* bg = F.in[11]; const float* be = F.in[13];
    for (int row = gw; row < T; row += NGW) {
        const GAS f32x4* xr = (const GAS f32x4*)(F.out + (size_t)row * D) + lane;
        f32x4 v[4]; float s = 0.f;
#pragma unroll
        for (int j = 0; j < 4; ++j) { v[j] = xr[64 * j]; s += (v[j].x * v[j].x + v[j].y * v[j].y) + (v[j].z * v[j].z + v[j].w * v[j].w); }
        const float rstd = rsqrtf(wave_sum(s) * (1.f / D) + 1e-6f);
        GAS v2u* o8 = (GAS v2u*)(U + (size_t)row * D) + lane;
#pragma unroll
        for (int j = 0; j < 4; ++j) { const f32x4 ww = ((const GAS f32x4*)nw)[lane + 64 * j]; v[j].x *= rstd * ww.x; v[j].y *= rstd * ww.y; v[j].z *= rstd * ww.z; v[j].w *= rstd * ww.w;
            v2u o; o.x = pk2(v[j].x, v[j].y); o.y = pk2(v[j].z, v[j].w); o8[64 * j] = o; }
        f32x4 gl = (f32x4){0.f, 0.f, 0.f, 0.f};
#pragma unroll
        for (int j = 0; j < 4; ++j) { const LAS f32x4* wp = (const LAS f32x4*)WGs + (lane + 64 * j) * 4;
            gl += wp[0] * v[j].x; gl += wp[1] * v[j].y; gl += wp[2] * v[j].z; gl += wp[3] * v[j].w; }
        gl.x = wave_sum(gl.x) + bg[0]; gl.y = wave_sum(gl.y) + bg[1]; gl.z = wave_sum(gl.z) + bg[2]; gl.w = wave_sum(gl.w) + bg[3];
        int gs = 0; float gm = gl.x;
        if (gl.y > gm) { gm = gl.y; gs = 1; } if (gl.z > gm) { gm = gl.z; gs = 2; } if (gl.w > gm) { gm = gl.w; gs = 3; }
        const float gw_ = 1.f / (expf(gl.x - gm) + expf(gl.y - gm) + expf(gl.z - gm) + expf(gl.w - gm));
        gs = __builtin_amdgcn_readfirstlane(gs);
        f32x4 e0 = (f32x4){0.f, 0.f, 0.f, 0.f}, e1 = e0;
#pragma unroll
        for (int j = 0; j < 4; ++j) { const LAS f32x4* wp = (const LAS f32x4*)WEs + (size_t)gs * 2048 + (lane + 64 * j) * 8;
            e0 += wp[0] * v[j].x; e1 += wp[1] * v[j].x; e0 += wp[2] * v[j].y; e1 += wp[3] * v[j].y; e0 += wp[4] * v[j].z; e1 += wp[5] * v[j].z; e0 += wp[6] * v[j].w; e1 += wp[7] * v[j].w; }
        float el[8];
        el[0] = wave_sum(e0.x); el[1] = wave_sum(e0.y); el[2] = wave_sum(e0.z); el[3] = wave_sum(e0.w); el[4] = wave_sum(e1.x); el[5] = wave_sum(e1.y); el[6] = wave_sum(e1.z); el[7] = wave_sum(e1.w);
#pragma unroll
        for (int e = 0; e < 8; ++e) el[e] += be[gs * 8 + e];
        int i0 = 0; float v0 = el[0];
#pragma unroll
        for (int e = 1; e < 8; ++e) if (el[e] > v0) { v0 = el[e]; i0 = e; }
        int i1 = -1; float v1 = -3.0e38f;
#pragma unroll
        for (int e = 0; e < 8; ++e) if (e != i0 && el[e] > v1) { v1 = el[e]; i1 = e; }
        const float ee = expf(v1 - v0), w0 = gw_ / (1.f + ee), w1 = gw_ * ee / (1.f + ee);
        if (lane == 0) {
            const int ex0 = gs * 8 + i0, ex1 = gs * 8 + i1;
            const unsigned s0 = atomicAdd(CNT + ex0, 1u), s1 = atomicAdd(CNT + ex1, 1u);
            LIST[(size_t)ex0 * T + s0] = row * 2; LIST[(size_t)ex1 * T + s1] = row * 2 + 1;
            WGT[row * 2] = w0; WGT[row * 2 + 1] = w1;
        }
    }
    __syncthreads();
    LAS float* scr = (LAS float*)(F.lds + RING_OFF + F.wave * 16384);
    bf16* WGU = (bf16*)(F.ws + WS_WGU); bf16* WD = (bf16*)(F.ws + WS_WD);
    for (int it = gw; it < 32 * 768; it += NGW) {
        const int e = it / 768, r = it % 768;
        if (r < 512) { const int gu = r >> 8, q = r & 255, kb = q >> 4, nb = q & 15, n0 = nb * 32;
            transpose_item((gu ? F.in[15] : F.in[14]) + (size_t)e * 1024 * 512, 512, kb * 64, n0, WGU + (size_t)e * 1024 * 1024, 1024, (n0 >> 7) * 256 + gu * 128 + (n0 & 127), scr, lane); }
        else { const int q = r - 512, kb = q >> 5, nb = q & 31;
            transpose_item(F.in[16] + (size_t)e * 512 * 1024, 1024, kb * 64, nb * 32, WD + (size_t)e * 1024 * 512, 512, nb * 32, scr, lane); }
    }
}

__device__ __forceinline__ void p9_final(Frame& F) {
    const int gw = F.vcu * NWAVES + F.wave, NGW = F.G * NWAVES, lane = F.lane;
    const bf16* Y = (const bf16*)(F.ws + WS_YBUF); const float* w = F.in[17];
    for (int row = gw; row < T; row += NGW) {
        GAS f32x4* xr = (GAS f32x4*)(F.out + (size_t)row * D) + lane;
        const GAS v2u* y0 = (const GAS v2u*)(Y + (size_t)(2 * row) * D) + lane; const GAS v2u* y1 = (const GAS v2u*)(Y + (size_t)(2 * row + 1) * D) + lane;
        f32x4 v[4]; float s = 0.f;
#pragma unroll
        for (int j = 0; j < 4; ++j) { v[j] = xr[64 * j]; const v2u a = y0[64 * j], b = y1[64 * j];
            v[j].x += __uint_as_float(a.x << 16) + __uint_as_float(b.x << 16); v[j].y += __uint_as_float(a.x & 0xffff0000u) + __uint_as_float(b.x & 0xffff0000u);
            v[j].z += __uint_as_float(a.y << 16) + __uint_as_float(b.y << 16); v[j].w += __uint_as_float(a.y & 0xffff0000u) + __uint_as_float(b.y & 0xffff0000u);
            s += (v[j].x * v[j].x + v[j].y * v[j].y) + (v[j].z * v[j].z + v[j].w * v[j].w); }
        const float rstd = rsqrtf(wave_sum(s) * (1.f / D) + 1e-6f);
#pragma unroll
        for (int j = 0; j < 4; ++j) { const f32x4 ww = ((const GAS f32x4*)w)[lane + 64 * j]; xr[64 * j] = (f32x4){v[j].x * rstd * ww.x, v[j].y * rstd * ww.y, v[j].z * rstd * ww.z, v[j].w * rstd * ww.w}; }
    }
}

__device__ __forceinline__ int moe_build_tab(Frame& F) {
    LAS int* tab = (LAS int*)(F.lds + TAB_OFF);
    if (F.tid == 0) { const unsigned* CNT = (const unsigned*)(F.ctl + CW_CNT); int R = 0;
        for (int e = 0; e < 32; ++e) { const int nt = ((int)CNT[e] + 255) >> 8; for (int rt = 0; rt < nt && R < 255; ++rt) tab[R++] = (e << 8) | rt; }
        tab[255] = R; }
    __syncthreads();
    const int NT = tab[255];
    return __builtin_amdgcn_readfirstlane(NT);
}


typedef float f32x2_t __attribute__((ext_vector_type(2))); typedef __bf16 bf16x2_t __attribute__((ext_vector_type(2)));
__device__ __forceinline__ unsigned cvtpk(float lo, float hi) { f32x2_t v = {lo, hi}; bf16x2_t b = __builtin_convertvector(v, bf16x2_t); return __builtin_bit_cast(unsigned, b); }
namespace att {
typedef short s16x4 __attribute__((ext_vector_type(4)));
typedef short v4i16_t __attribute__((ext_vector_type(4)));
constexpr int KOFF = 0, VOFF = 49152, QOFF = 98304;
constexpr float QSCALE = 0.125f * 1.4426950408889634f;
__device__ __forceinline__ int swz_off(int r, int ch) { return r * 128 + ((ch ^ ((r >> 1) & 7)) << 4); }
__device__ __forceinline__ s16x4 vtr(const LAS unsigned char* p) { return __builtin_bit_cast(s16x4, __builtin_amdgcn_ds_read_tr16_b64_v4i16((LAS v4i16_t*)p)); }
__device__ __forceinline__ float blo(unsigned u) { return __uint_as_float(u << 16); }
__device__ __forceinline__ float bhi(unsigned u) { return __uint_as_float(u & 0xffff0000u); }

__device__ __forceinline__ void rope16(v4u& a, v4u& b, const float* rp, float sc) {
    const f32x4 c0 = *(const GAS f32x4*)rp, c1 = *(const GAS f32x4*)(rp + 4), s0 = *(const GAS f32x4*)(rp + 8), s1 = *(const GAS f32x4*)(rp + 12);
    const float cs[8] = {c0.x, c0.y, c0.z, c0.w, c1.x, c1.y, c1.z, c1.w}, sn[8] = {s0.x, s0.y, s0.z, s0.w, s1.x, s1.y, s1.z, s1.w};
    float t1[8], t2[8];
#pragma unroll
    for (int i = 0; i < 4; ++i) { t1[2 * i] = blo(a[i]); t1[2 * i + 1] = bhi(a[i]); t2[2 * i] = blo(b[i]); t2[2 * i + 1] = bhi(b[i]); }
#pragma unroll
    for (int i = 0; i < 4; ++i) {
        a[i] = pk2((t1[2 * i] * cs[2 * i] - t2[2 * i] * sn[2 * i]) * sc, (t1[2 * i + 1] * cs[2 * i + 1] - t2[2 * i + 1] * sn[2 * i + 1]) * sc);
        b[i] = pk2((t2[2 * i] * cs[2 * i] + t1[2 * i] * sn[2 * i]) * sc, (t2[2 * i + 1] * cs[2 * i + 1] + t1[2 * i + 1] * sn[2 * i + 1]) * sc);
    }
}
__device__ __forceinline__ void scale16(v4u& a, v4u& b, float sc) {
#pragma unroll
    for (int i = 0; i < 4; ++i) { a[i] = pk2(blo(a[i]) * sc, bhi(a[i]) * sc); b[i] = pk2(blo(b[i]) * sc, bhi(b[i]) * sc); }
}

__device__ __forceinline__ void attn_unit(Frame& F, int unit) {
    const int p = unit >> 9, b = (unit >> 8) & 1, h = (unit >> 5) & 7, cj = unit & 31;
    const int dl = 2 * p, d = 1 << dl, L = SEQ >> dl, nb = L >> 8;
    const int c = cj / nb, jb = cj - c * nb, i0 = jb * 256;
    const bf16* proj = (const bf16*)(F.ws + WS_PROJ); const float* rope = (const float*)(F.ws + WS_ROPE);
    LAS unsigned char* lds = F.lds;
    const int tid = F.tid, lane = F.lane, w = F.wave;
    {
        v4u ra[8], rb[8]; int pos8[8];
#pragma unroll
        for (int it = 0; it < 8; ++it) {
            const int task = tid + 512 * it;
            const int kind = it < 3 ? 0 : (it < 6 ? 1 : 2);
            const int tl = task - (kind == 0 ? 0 : (kind == 1 ? 1536 : 3072));
            const int r = tl >> 2, g4 = tl & 3;
            const int i = (kind == 2) ? (i0 + r) : (i0 - 64 + r);
            const bool valid = (i >= 0) && (i < L);
            const int pos = i * d + c; pos8[it] = valid ? pos : -1;
            const int col = (kind == 0 ? C_AK : (kind == 1 ? C_AV : C_AQ)) + h * 64 + g4 * 16;
            if (valid) { const GAS v4u* src = (const GAS v4u*)(proj + (size_t)(b * SEQ + pos) * PP + col); ra[it] = src[0]; rb[it] = src[1]; }
            else { ra[it] = (v4u){0u, 0u, 0u, 0u}; rb[it] = (v4u){0u, 0u, 0u, 0u}; }
        }
#pragma unroll
        for (int it = 0; it < 8; ++it) {
            const int task = tid + 512 * it;
            const int kind = it < 3 ? 0 : (it < 6 ? 1 : 2);
            const int tl = task - (kind == 0 ? 0 : (kind == 1 ? 1536 : 3072));
            const int r = tl >> 2, g4 = tl & 3;
            if (kind != 1) {
                if (g4 == 0 && pos8[it] >= 0) rope16(ra[it], rb[it], rope + (size_t)pos8[it] * 16, kind == 2 ? QSCALE : 1.0f);
                else if (kind == 2) scale16(ra[it], rb[it], QSCALE);
            }
            const int base = kind == 0 ? KOFF : (kind == 1 ? VOFF : QOFF);
            *(LAS v4u*)(lds + base + swz_off(r, 2 * g4)) = ra[it];
            *(LAS v4u*)(lds + base + swz_off(r, 2 * g4 + 1)) = rb[it];
        }
    }
    __syncthreads();
    const int fr = lane & 15, g = lane >> 4, q4 = fr >> 2, p4 = fr & 3;
    bf16* opart = (bf16*)(F.ws + WS_PART) + (size_t)p * T * 512;
    float* lse = (float*)(F.ws + WS_PART + (size_t)48 * MiB) + (size_t)p * T * 8;
#pragma unroll
    for (int tt = 0; tt < 2; ++tt) {
        const int ql = 32 * w + 16 * tt + fr;
        bf16x8 qf[2];
#pragma unroll
        for (int s = 0; s < 2; ++s) qf[s] = *(const LAS bf16x8*)(lds + QOFF + swz_off(ql, 4 * s + g));
        f32x4 st[10];
#pragma unroll
        for (int ut = 0; ut < 10; ++ut) {
            st[ut] = (f32x4){0.f, 0.f, 0.f, 0.f};
#pragma unroll
            for (int s = 0; s < 2; ++s) { const bf16x8 kf = *(const LAS bf16x8*)(lds + KOFF + swz_off(32 * w + 16 * ut + fr, 4 * s + g));
                st[ut] = __builtin_amdgcn_mfma_f32_16x16x32_bf16(kf, qf[s], st[ut], 0, 0, 0); }
        }
        float m = -INFINITY;
#pragma unroll
        for (int ut = 0; ut < 10; ++ut)
#pragma unroll
            for (int i = 0; i < 4; ++i) { const int ku = 32 * w + 16 * ut + 4 * g + i, ik = i0 - 64 + ku;
                const bool valid = (ku >= ql) && (ku <= ql + 128) && (ik >= 0) && (ik < L);
                st[ut][i] = valid ? st[ut][i] : -INFINITY; m = fmaxf(m, st[ut][i]); }
        m = fmaxf(m, __shfl_xor(m, 16)); m = fmaxf(m, __shfl_xor(m, 32));
        float l = 0.f;
#pragma unroll
        for (int ut = 0; ut < 10; ++ut)
#pragma unroll
            for (int i = 0; i < 4; ++i) { st[ut][i] = __builtin_amdgcn_exp2f(st[ut][i] - m); l += st[ut][i]; }
        l += __shfl_xor(l, 16); l += __shfl_xor(l, 32);
        f32x4 o[4];
#pragma unroll
        for (int vt = 0; vt < 4; ++vt) o[vt] = (f32x4){0.f, 0.f, 0.f, 0.f};
#pragma unroll
        for (int kp = 0; kp < 5; ++kp) {
            v4u pw; pw.x = cvtpk(st[2 * kp][0], st[2 * kp][1]); pw.y = cvtpk(st[2 * kp][2], st[2 * kp][3]);
            pw.z = cvtpk(st[2 * kp + 1][0], st[2 * kp + 1][1]); pw.w = cvtpk(st[2 * kp + 1][2], st[2 * kp + 1][3]);
            const bf16x8 pf = __builtin_bit_cast(bf16x8, pw);
            const int r0 = 32 * w + 32 * kp + 4 * g + q4, r1 = r0 + 16;
#pragma unroll
            for (int vt = 0; vt < 4; ++vt) {
                const s16x4 a0 = vtr(lds + VOFF + swz_off(r0, 2 * vt + (p4 >> 1)) + 8 * (p4 & 1));
                const s16x4 a1 = vtr(lds + VOFF + swz_off(r1, 2 * vt + (p4 >> 1)) + 8 * (p4 & 1));
                const bf16x8 af = __builtin_shufflevector(a0, a1, 0, 1, 2, 3, 4, 5, 6, 7);
                o[vt] = __builtin_amdgcn_mfma_f32_16x16x32_bf16(af, pf, o[vt], 0, 0, 0);
            }
        }
        const float inv = 1.0f / l;
        const size_t tok = (size_t)b * SEQ + (size_t)(i0 + ql) * d + c;
#pragma unroll
        for (int vt = 0; vt < 4; ++vt) { v2u ov; ov.x = cvtpk(o[vt][0] * inv, o[vt][1] * inv); ov.y = cvtpk(o[vt][2] * inv, o[vt][3] * inv);
            *(GAS v2u*)(opart + tok * 512 + h * 64 + 16 * vt + 4 * g) = ov; }
        if (g == 0) lse[tok * 8 + h] = m + __builtin_amdgcn_logf(l);
    }
    __syncthreads();
}

__device__ __forceinline__ void attn_merge(Frame& F) {
    const bf16* opart = (const bf16*)(F.ws + WS_PART); const float* lse = (const float*)(F.ws + WS_PART + (size_t)48 * MiB);
    bf16* mixed = (bf16*)(F.ws + WS_U);
    for (int task = blockIdx.x * 512 + F.tid; task < T * 64; task += F.G * 512) {
        const int tok = task >> 6, hc = task & 63, h = hc >> 3;
        const float l0 = lse[(size_t)tok * 8 + h], l1 = lse[(size_t)T * 8 + (size_t)tok * 8 + h], l2 = lse[(size_t)2 * T * 8 + (size_t)tok * 8 + h];
        const float mx = fmaxf(l0, fmaxf(l1, l2));
        float w0 = __builtin_amdgcn_exp2f(l0 - mx), w1 = __builtin_amdgcn_exp2f(l1 - mx), w2 = __builtin_amdgcn_exp2f(l2 - mx);
        const float inv = 1.0f / (w0 + w1 + w2); w0 *= inv; w1 *= inv; w2 *= inv;
        const size_t off = (size_t)tok * 512 + hc * 8;
        const v4u a = *(const GAS v4u*)(opart + off), bq = *(const GAS v4u*)(opart + (size_t)T * 512 + off), cq = *(const GAS v4u*)(opart + (size_t)2 * T * 512 + off);
        v4u o;
#pragma unroll
        for (int i = 0; i < 4; ++i) o[i] = pk2(w0 * blo(a[i]) + w1 * blo(bq[i]) + w2 * blo(cq[i]), w0 * bhi(a[i]) + w1 * bhi(bq[i]) + w2 * bhi(cq[i]));
        *(GAS v4u*)(mixed + (size_t)tok * D + 512 + hc * 8) = o;
    }
}
}


namespace gla {
using att::s16x4; using att::vtr; using att::blo; using att::bhi;
constexpr int IMG = 0, VIMG = 32768, LRO = 49152, SEG = 57344, SSQ = 59392;
__device__ __forceinline__ int swz64(int r, int ch) { return r * 128 + ((ch ^ ((r >> 1) & 7)) << 4); }
__device__ __forceinline__ int swzV(int r, int ch) { return r * 256 + ((ch ^ ((r & 7) << 1)) << 4); }
__device__ __forceinline__ float fexp(float x) { return __builtin_amdgcn_exp2f(x * 1.4426950408889634f); }

template <int MODE>
__device__ __forceinline__ void gla_prep(Frame& F, int b, int n, int h) {
    const bf16* proj = (const bf16*)(F.ws + WS_PROJ);
    LAS unsigned char* lds = F.lds; const int tid = F.tid;
    const int dir = tid >> 8, seg = (tid >> 6) & 3, d = tid & 63;
    const size_t tok0 = (size_t)b * SEQ + (size_t)n * 64;
    { const int t = tid >> 3, c4 = (tid & 7) * 4;
      const v2u raw = *(const GAS v2u*)(proj + (tok0 + t) * PP + C_LF + c4);
      *(LAS f32x4*)(lds + LRO + (t * 32 + c4) * 4) = (f32x4){blo(raw.x), bhi(raw.x), blo(raw.y), bhi(raw.y)}; }
#pragma unroll
    for (int it = 0; it < 2; ++it) { const int task = tid + 512 * it, t = task >> 4, ch = task & 15;
      *(LAS v4u*)(lds + VIMG + swzV(t, ch)) = *(const GAS v4u*)(proj + (tok0 + t) * PP + C_GV + h * 128 + ch * 8); }
    const float* W = dir ? F.in[5] : F.in[3]; const float* Bv = dir ? F.in[6] : F.in[4];
    float wr[16];
#pragma unroll
    for (int r = 0; r < 16; ++r) wr[r] = W[r * 256 + h * 64 + d];
    const float bias = Bv[h * 64 + d];
    float kv_[16], qv_[16];
#pragma unroll
    for (int i = 0; i < 16; ++i) { const size_t row = (tok0 + seg * 16 + i) * PP; kv_[i] = bf2f(proj[row + C_GK + h * 64 + d]); if (MODE == 1) qv_[i] = bf2f(proj[row + C_GQ + h * 64 + d]) * 0.125f; }
    __syncthreads();
    float c[16];
#pragma unroll
    for (int i = 0; i < 16; ++i) { const LAS f32x4* lp = (const LAS f32x4*)(lds + LRO + ((seg * 16 + i) * 32 + dir * 16) * 4);
        float z = bias;
#pragma unroll
        for (int r4 = 0; r4 < 4; ++r4) { const f32x4 lv = lp[r4]; z += lv.x * wr[4 * r4] + lv.y * wr[4 * r4 + 1] + lv.z * wr[4 * r4 + 2] + lv.w * wr[4 * r4 + 3]; }
        c[i] = (fminf(z, 0.f) - __builtin_amdgcn_logf(1.0f + fexp(-fabsf(z))) * 0.6931471805599453f) * 0.0625f; }
    if (dir == 0) {
#pragma unroll
        for (int i = 1; i < 16; ++i) c[i] += c[i - 1]; }
    else {
#pragma unroll
        for (int i = 14; i >= 0; --i) c[i] += c[i + 1]; }
    LAS float* segp = (LAS float*)(lds + SEG);
    segp[(dir * 4 + seg) * 64 + d] = dir == 0 ? c[15] : c[0];
    __syncthreads();
    float offs = 0.f, tot = 0.f;
#pragma unroll
    for (int s = 0; s < 4; ++s) { const float sv = segp[(dir * 4 + s) * 64 + d]; tot += sv; if (dir == 0 ? (s < seg) : (s > seg)) offs += sv; }
#pragma unroll
    for (int i = 0; i < 16; ++i) { const int t = seg * 16 + i; const float bb = c[i] + offs;
        const int eo = swz64(t, d >> 3) + (d & 7) * 2;
        if (MODE == 0) { *(LAS bf16*)(lds + IMG + dir * 8192 + eo) = f2bf(kv_[i] * fexp(tot - bb)); }
        else { *(LAS bf16*)(lds + IMG + (2 * dir) * 8192 + eo) = f2bf(qv_[i] * fexp(bb)); *(LAS bf16*)(lds + IMG + (2 * dir + 1) * 8192 + eo) = f2bf(kv_[i] * fexp(-bb)); } }
    if (MODE == 0 && seg == 0) { float* dec = (float*)(F.ws + WS_DEC); dec[((size_t)((b * 4 + h) * 2 + dir) * 128 + n) * 64 + d] = fexp(tot); }
    __syncthreads();
}

__device__ __forceinline__ void gla_unit_a(Frame& F, int unit) {
    const int b = unit >> 9, n = (unit >> 2) & 127, h = unit & 3;
    gla_prep<0>(F, b, n, h);
    LAS unsigned char* lds = F.lds; const int lane = F.lane, w = F.wave;
    const int fr = lane & 15, g = lane >> 4, q4 = fr >> 2, p4 = fr & 3;
    const int dir = w >> 2, vcp = w & 3;
    f32x4 acc[4][2];
#pragma unroll
    for (int dt = 0; dt < 4; ++dt)
#pragma unroll
        for (int v = 0; v < 2; ++v) acc[dt][v] = (f32x4){0.f, 0.f, 0.f, 0.f};
#pragma unroll
    for (int s = 0; s < 2; ++s) {
        const int r0 = 32 * s + 8 * g + q4, r1 = r0 + 4;
        bf16x8 vf[2];
#pragma unroll
        for (int v = 0; v < 2; ++v) { const int ch = 2 * (2 * vcp + v) + (p4 >> 1);
            const s16x4 a0 = vtr(lds + VIMG + swzV(r0, ch) + 8 * (p4 & 1)), a1 = vtr(lds + VIMG + swzV(r1, ch) + 8 * (p4 & 1));
            vf[v] = __builtin_shufflevector(a0, a1, 0, 1, 2, 3, 4, 5, 6, 7); }
#pragma unroll
        for (int dt = 0; dt < 4; ++dt) { const int ch = 2 * dt + (p4 >> 1);
            const s16x4 a0 = vtr(lds + IMG + dir * 8192 + swz64(r0, ch) + 8 * (p4 & 1)), a1 = vtr(lds + IMG + dir * 8192 + swz64(r1, ch) + 8 * (p4 & 1));
            const bf16x8 kf = __builtin_shufflevector(a0, a1, 0, 1, 2, 3, 4, 5, 6, 7);
#pragma unroll
            for (int v = 0; v < 2; ++v) acc[dt][v] = __builtin_amdgcn_mfma_f32_16x16x32_bf16(kf, vf[v], acc[dt][v], 0, 0, 0); }
    }
    bf16* kvb = (bf16*)(F.ws + WS_KV) + ((size_t)((b * 4 + h) * 2 + dir) * 128 + n) * 8192;
#pragma unroll
    for (int dt = 0; dt < 4; ++dt)
#pragma unroll
        for (int v = 0; v < 2; ++v) { const int vc = 16 * (2 * vcp + v) + fr; v2u o; o.x = cvtpk(acc[dt][v][0], acc[dt][v][1]); o.y = cvtpk(acc[dt][v][2], acc[dt][v][3]);
            *(GAS v2u*)(kvb + vc * 64 + 16 * dt + 4 * g) = o; }
    __syncthreads();
}

__device__ __forceinline__ void gla_scan(Frame& F) {
    if (F.tid >= 256) return;
    for (int e2 = blockIdx.x * 256 + F.tid; e2 < 65536; e2 += F.G * 256) {
    const int combo = e2 >> 12, rem = e2 & 4095, d2 = rem & 31, dir = combo & 1;
    unsigned* kvw = (unsigned*)(F.ws + WS_KV) + (size_t)combo * 128 * 4096 + rem;
    const float* dec = (const float*)(F.ws + WS_DEC) + (size_t)combo * 128 * 64 + 2 * d2;
    float s0 = 0.f, s1 = 0.f;
    for (int nb = 0; nb < 128; nb += 8) {
        unsigned kvr[8]; float2 dc[8];
#pragma unroll
        for (int j = 0; j < 8; ++j) { const int n = dir ? (127 - nb - j) : (nb + j); kvr[j] = kvw[(size_t)n * 4096]; dc[j] = *(const float2*)(dec + n * 64); }
#pragma unroll
        for (int j = 0; j < 8; ++j) { const int n = dir ? (127 - nb - j) : (nb + j);
            kvw[(size_t)n * 4096] = pk2(s0, s1);
            s0 = s0 * dc[j].x + blo(kvr[j]); s1 = s1 * dc[j].y + bhi(kvr[j]); }
    }
    }
}

__device__ __forceinline__ void gla_unit_c(Frame& F, int unit) {
    const int b = unit >> 9, n = (unit >> 2) & 127, h = unit & 3;
    gla_prep<1>(F, b, n, h);
    const bf16* proj = (const bf16*)(F.ws + WS_PROJ);
    LAS unsigned char* lds = F.lds; const int lane = F.lane, w = F.wave;
    const int fr = lane & 15, g = lane >> 4, q4 = fr >> 2, p4 = fr & 3;
    const int tt = w & 3, vh = w >> 2;
    f32x4 o[4];
#pragma unroll
    for (int vt = 0; vt < 4; ++vt) o[vt] = (f32x4){0.f, 0.f, 0.f, 0.f};
    const int tq = 16 * tt + fr;
#pragma unroll
    for (int dir = 0; dir < 2; ++dir) {
        bf16x8 qf[2];
#pragma unroll
        for (int s = 0; s < 2; ++s) qf[s] = *(const LAS bf16x8*)(lds + IMG + (2 * dir) * 8192 + swz64(tq, 4 * s + g));
        f32x4 st[4];
#pragma unroll
        for (int ut = 0; ut < 4; ++ut) { st[ut] = (f32x4){0.f, 0.f, 0.f, 0.f};
#pragma unroll
            for (int s = 0; s < 2; ++s) { const bf16x8 kf = *(const LAS bf16x8*)(lds + IMG + (2 * dir + 1) * 8192 + swz64(16 * ut + fr, 4 * s + g));
                st[ut] = __builtin_amdgcn_mfma_f32_16x16x32_bf16(kf, qf[s], st[ut], 0, 0, 0); }
#pragma unroll
            for (int i = 0; i < 4; ++i) { const int u = 16 * ut + 4 * g + i; const bool keep = dir == 0 ? (u <= tq) : (u >= tq); st[ut][i] = keep ? st[ut][i] : 0.f; } }
        const bf16* stb = (const bf16*)(F.ws + WS_KV) + ((size_t)((b * 4 + h) * 2 + dir) * 128 + n) * 8192;
#pragma unroll
        for (int kp = 0; kp < 2; ++kp) {
            v4u pw; pw.x = cvtpk(st[2 * kp][0], st[2 * kp][1]); pw.y = cvtpk(st[2 * kp][2], st[2 * kp][3]);
            pw.z = cvtpk(st[2 * kp + 1][0], st[2 * kp + 1][1]); pw.w = cvtpk(st[2 * kp + 1][2], st[2 * kp + 1][3]);
            const bf16x8 pf = __builtin_bit_cast(bf16x8, pw);
            const int r0 = 32 * kp + 4 * g + q4, r1 = r0 + 16;
#pragma unroll
            for (int vt = 0; vt < 4; ++vt) { const int ch = 8 * vh + 2 * vt + (p4 >> 1);
                const s16x4 a0 = vtr(lds + VIMG + swzV(r0, ch) + 8 * (p4 & 1)), a1 = vtr(lds + VIMG + swzV(r1, ch) + 8 * (p4 & 1));
                const bf16x8 af = __builtin_shufflevector(a0, a1, 0, 1, 2, 3, 4, 5, 6, 7);
                o[vt] = __builtin_amdgcn_mfma_f32_16x16x32_bf16(af, pf, o[vt], 0, 0, 0); }
        }
#pragma unroll
        for (int s = 0; s < 2; ++s)
#pragma unroll
            for (int vt = 0; vt < 4; ++vt) { const bf16x8 sf = *(const GAS bf16x8*)(stb + (size_t)(64 * vh + 16 * vt + fr) * 64 + 32 * s + 8 * g);
                o[vt] = __builtin_amdgcn_mfma_f32_16x16x32_bf16(sf, qf[s], o[vt], 0, 0, 0); }
    }
    float ss = 0.f;
#pragma unroll
    for (int vt = 0; vt < 4; ++vt) ss += (o[vt][0] * o[vt][0] + o[vt][1] * o[vt][1]) + (o[vt][2] * o[vt][2] + o[vt][3] * o[vt][3]);
    ss += __shfl_xor(ss, 16); ss += __shfl_xor(ss, 32);
    LAS float* ssq = (LAS float*)(lds + SSQ);
    if (g == 0) ssq[vh * 64 + tq] = ss;
    __syncthreads();
    const float rstd = rsqrtf((ssq[tq] + ssq[64 + tq]) * (1.0f / 128.0f) + 1e-6f);
    const size_t tok = (size_t)b * SEQ + (size_t)n * 64 + tq;
    bf16* mixed = (bf16*)(F.ws + WS_U);
#pragma unroll
    for (int vt = 0; vt < 4; ++vt) { const int vc = 64 * vh + 16 * vt + 4 * g;
        const v2u gr = *(const GAS v2u*)(proj + tok * PP + C_GG + h * 128 + vc); const f32x4 nw = *(const GAS f32x4*)(F.in[7] + vc);
        const float g0 = blo(gr.x), g1 = bhi(gr.x), g2 = blo(gr.y), g3 = bhi(gr.y);
        v2u ov; ov.x = cvtpk(pg8::silu_mul(g0, o[vt][0] * rstd * nw.x), pg8::silu_mul(g1, o[vt][1] * rstd * nw.y));
        ov.y = cvtpk(pg8::silu_mul(g2, o[vt][2] * rstd * nw.z), pg8::silu_mul(g3, o[vt][3] * rstd * nw.w));
        *(GAS v2u*)(mixed + tok * D + h * 128 + vc) = ov; }
    __syncthreads();
}
}

struct Args { const float* in[18]; float* out; unsigned char* ws; int ph_lo, ph_hi, li, pad; };
__global__ void __launch_bounds__(NWAVES * 64, 2) mk_fwd(Args args) {
    extern __shared__ __attribute__((aligned(16))) unsigned char lds[];
    Frame F;
    F.lds = (LAS unsigned char*)lds;
    F.MISC = (volatile LAS unsigned*)(F.lds + MISC_OFF);
    F.tid = threadIdx.x; F.lane = F.tid & 63; F.wave = __builtin_amdgcn_readfirstlane(F.tid >> 6);
    F.G = gridDim.x; { const int bx = blockIdx.x; F.vcu = (F.G % 8 == 0) ? (bx % 8) * (F.G / 8) + bx / 8 : bx; }
    F.ws = args.ws; F.out = args.out; F.ctl = (gu32*)(args.ws + WS_CTL);
#pragma unroll
    for (int i = 0; i < 18; ++i) F.in[i] = args.in[i];
    for (int u = F.tid; u < (LDS_BYTES - TAB_OFF) / 4; u += NWAVES * 64) ((LAS unsigned*)(F.lds + TAB_OFF))[u] = 0u;
    __syncthreads();
    XcdBarrier bar = xcd_barrier_post((unsigned*)(F.ctl + CW_BAR) + args.li * XCD_BAR_WORDS, F.MISC + 8);
    const int lo = args.ph_lo, hi = args.ph_hi;
#define IN(k) (lo <= (k) && (k) < hi)
#define BOTH(k) (IN(k) && IN((k) + 1))
#define GRID_BAR() xcd_barrier(bar)

    if (IN(0)) { p0_prologue(F); if (BOTH(0)) GRID_BAR(); }

    if (IN(1)) {
        pg8::StaticOrder S; S.init(F.ws + WS_U, F.ws + WS_WIN, T, PP, D, F.G, (int)blockIdx.x);
        pg8::EpiBf16 E{(bf16*)(F.ws + WS_PROJ), PP};
        pg8::gemm_phase<pg8::EpiBf16, pg8::StaticOrder, false, true>(F.lds + RING_OFF, D, S, E);
        if (BOTH(1)) GRID_BAR();
    }

    if (IN(2)) {
        if (args.pad & 1) for (int u = blockIdx.x; u < 1024; u += F.G) gla::gla_unit_a(F, u);
        if (args.pad & 2) for (int u = blockIdx.x; u < 1536; u += F.G) att::attn_unit(F, u);
        if (BOTH(2)) GRID_BAR(); }

    if (IN(3)) { gla::gla_scan(F); if (BOTH(3)) GRID_BAR(); }

    if (IN(4)) {
        if (args.pad & 1) for (int u = blockIdx.x; u < 1024; u += F.G) gla::gla_unit_c(F, u);
        if (args.pad & 2) att::attn_merge(F);
        if (BOTH(4)) GRID_BAR(); }

    if (IN(5)) {
        pg8::StaticOrder S; S.init(F.ws + WS_U, F.ws + WS_WOUT, T, D, D, F.G, (int)blockIdx.x);
        pg8::EpiF32Res E{F.out, F.in[0], D};
        pg8::gemm_phase<pg8::EpiF32Res, pg8::StaticOrder, false, false>(F.lds + RING_OFF, D, S, E);
        if (BOTH(5)) GRID_BAR();
    }

    if (IN(6)) { p6_router(F); if (BOTH(6)) GRID_BAR(); }

    if (IN(7)) {
        const int NT = moe_build_tab(F);
        pg8::MoeOrder<true> S{(const char*)(F.ws + WS_U), (const char*)(F.ws + WS_WGU), (size_t)1024 * 1024 * 2, D, NT * 4, F.G, (int)blockIdx.x,
                              (const LAS int*)(F.lds + TAB_OFF), (const unsigned*)(F.ctl + CW_CNT), (const int*)(F.ws + WS_LIST)};
        pg8::EpiGateUp E{(bf16*)(F.ws + WS_ACT)};
        pg8::gemm_phase<pg8::EpiGateUp, pg8::MoeOrder<true>, true, true>(F.lds + RING_OFF, D, S, E);
        if (BOTH(7)) GRID_BAR();
    }

    if (IN(8)) {
        const int NT = moe_build_tab(F);
        pg8::MoeOrder<false> S{(const char*)(F.ws + WS_ACT), (const char*)(F.ws + WS_WD), (size_t)1024 * 512 * 2, 512, NT * 4, F.G, (int)blockIdx.x,
                               (const LAS int*)(F.lds + TAB_OFF), (const unsigned*)(F.ctl + CW_CNT), (const int*)(F.ws + WS_LIST)};
        pg8::EpiDown E{(bf16*)(F.ws + WS_YBUF), (const int*)(F.ws + WS_LIST), (const unsigned*)(F.ctl + CW_CNT), (const float*)(F.ws + WS_WGT)};
        pg8::gemm_phase<pg8::EpiDown, pg8::MoeOrder<false>, false, true>(F.lds + RING_OFF, 512, S, E);
        if (BOTH(8)) GRID_BAR();
    }

    if (IN(9)) { p9_final(F); }
#undef IN
#undef BOTH
#undef GRID_BAR
}

#ifndef OPT_MOE
#define OPT_MOE 1
#endif
static void launch_mk(const Args& base, int lo, int hi, int li, int grid, hipStream_t stream, int sub = 3) {
    Args a = base; a.ph_lo = lo; a.ph_hi = hi; a.li = li; a.pad = sub;
    hipLaunchKernelGGL(mk_fwd, dim3(grid), dim3(NWAVES * 64), LDS_BYTES, stream, a);
}
extern "C" void kernel_launch(void* const* d_in, const int* in_sizes, int n_in, void* d_out, int out_size, void* d_ws, size_t ws_size, hipStream_t stream) {
    static int grid = 0;
    if (grid == 0) {
        int dev = 0, cus = 0;
        if (hipGetDevice(&dev) != hipSuccess || hipDeviceGetAttribute(&cus, hipDeviceAttributeMultiprocessorCount, dev) != hipSuccess) { grid = -1; return; }
        if (hipFuncSetAttribute((const void*)mk_fwd, hipFuncAttributeMaxDynamicSharedMemorySize, LDS_BYTES) != hipSuccess) { fprintf(stderr, "kernel_launch: hipFuncSetAttribute failed\n"); grid = -1; return; }
        (void)hipGetLastError();
        grid = cus;
    }
    if (grid < 0) return;
    const float* x = (const float*)d_in[0];
    const float* wf = (const float*)d_in[3]; const float* bfv = (const float*)d_in[4]; const float* wb = (const float*)d_in[5]; const float* bb = (const float*)d_in[6];
    const float* gnw = (const float*)d_in[7]; const float* norm2_w = (const float*)d_in[9];
    const float* rgw = (const float*)d_in[10]; const float* rgb = (const float*)d_in[11]; const float* rew = (const float*)d_in[12]; const float* reb = (const float*)d_in[13];
    const float* ewg = (const float*)d_in[14]; const float* ewu = (const float*)d_in[15]; const float* ewd = (const float*)d_in[16]; const float* fnw = (const float*)d_in[17];
    unsigned char* ws = (unsigned char*)d_ws; float* out = (float*)d_out;
    bf16* U = (bf16*)(ws + WS_U); bf16* PROJ = (bf16*)(ws + WS_PROJ); float* ODIR = (float*)(ws + WS_PART); bf16* YBUF = (bf16*)(ws + WS_YBUF);
    unsigned* CNT = (unsigned*)(ws + WS_CTL) + CW_CNT; int* LIST = (int*)(ws + WS_LIST); float* WGT = (float*)(ws + WS_WGT);
    (void)hipMemsetAsync(ws + WS_CTL, 0, 1 * MiB, stream);
    Args a{};
    for (int i = 0; i < 18; ++i) a.in[i] = (const float*)d_in[i];
    a.out = out; a.ws = ws;
    launch_mk(a, 0, 10, 0, grid, stream, 3);
}
```

```cpp
#include <hip/hip_runtime.h>
#include <cstdio>
#include <cstdint>

typedef unsigned short bf16;
constexpr int T = 16384, SEQ = 8192, D = 1024;
constexpr int PP = 3328;
constexpr int C_GQ = 0, C_GK = 256, C_GV = 512, C_GG = 1024, C_AQ = 1536, C_AK = 2048, C_AV = 2560, C_LF = 3072, C_LB = 3088;
constexpr int INW = 3104;
constexpr size_t MiB = 1u << 20;
constexpr size_t WS_CTL = 0, WS_U = 10 * MiB, WS_PROJ = 42 * MiB, WS_KV = 146 * MiB, WS_PART = 178 * MiB, WS_YBUF = 186 * MiB,
                 WS_LIST = 250 * MiB, WS_WGT = 252 * MiB;
constexpr int CW_CNT = 1024;

__device__ __forceinline__ float bf2f(bf16 b) { return __uint_as_float(((unsigned)b) << 16); }
__device__ __forceinline__ bf16 f2bf(float f) { unsigned u = __float_as_uint(f); return (bf16)((u + 0x7fffu + ((u >> 16) & 1u)) >> 16); }
__device__ __forceinline__ float wave_sum(float v) {
#pragma unroll
    for (int o = 1; o < 64; o <<= 1) v += __shfl_xor(v, o);
    return v;
}

__global__ __launch_bounds__(256) void k_rms_bf16(const float* x, const float* w, bf16* out) {
    const int row = blockIdx.x * 4 + (threadIdx.x >> 6), lane = threadIdx.x & 63;
    const float4* xr = (const float4*)(x + (size_t)row * D) + lane;
    float4 v[4]; float s = 0.f;
#pragma unroll
    for (int j = 0; j < 4; ++j) { v[j] = xr[64 * j]; s += v[j].x * v[j].x + v[j].y * v[j].y + v[j].z * v[j].z + v[j].w * v[j].w; }
    const float rstd = rsqrtf(wave_sum(s) * (1.f / D) + 1e-6f);
#pragma unroll
    for (int j = 0; j < 4; ++j) {
        const float4 ww = ((const float4*)w)[lane + 64 * j];
        bf16* o = out + (size_t)row * D + (lane + 64 * j) * 4;
        o[0] = f2bf(v[j].x * rstd * ww.x); o[1] = f2bf(v[j].y * rstd * ww.y); o[2] = f2bf(v[j].z * rstd * ww.z); o[3] = f2bf(v[j].w * rstd * ww.w);
    }
}

template <int MODE>
__global__ __launch_bounds__(256) void k_gemm_naive(const bf16* A, int lda, const float* B, int ldb, int K, bf16* Cb, float* Cf, const float* res) {
    __shared__ float As[16][68];
    __shared__ float Bs[16][68];
    const int tx = threadIdx.x & 15, ty = threadIdx.x >> 4;
    const int m0 = blockIdx.y * 64, n0 = blockIdx.x * 64;
    float acc[4][4];
#pragma unroll
    for (int i = 0; i < 4; ++i)
#pragma unroll
        for (int j = 0; j < 4; ++j) acc[i][j] = 0.f;
    for (int k0 = 0; k0 < K; k0 += 16) {
#pragma unroll
        for (int i = 0; i < 4; ++i) { const int e = threadIdx.x + i * 256, r = e >> 4, kk = e & 15; As[kk][r] = bf2f(A[(size_t)(m0 + r) * lda + k0 + kk]); }
#pragma unroll
        for (int i = 0; i < 4; ++i) { const int e = threadIdx.x + i * 256, kk = e >> 6, c = e & 63; int n = n0 + c, oc;
            if (MODE == 0) oc = n < 1536 ? n : (n < 3072 ? n + 32 : (n < 3104 ? n - 1536 : -1)); else oc = n;
            Bs[kk][c] = oc >= 0 ? B[(size_t)(k0 + kk) * ldb + oc] : 0.f; }
        __syncthreads();
#pragma unroll
        for (int kk = 0; kk < 16; ++kk) {
            float a[4], b[4];
#pragma unroll
            for (int i = 0; i < 4; ++i) { a[i] = As[kk][ty * 4 + i]; b[i] = Bs[kk][tx * 4 + i]; }
#pragma unroll
            for (int i = 0; i < 4; ++i)
#pragma unroll
                for (int j = 0; j < 4; ++j) acc[i][j] += a[i] * b[j];
        }
        __syncthreads();
    }
#pragma unroll
    for (int i = 0; i < 4; ++i)
#pragma unroll
        for (int j = 0; j < 4; ++j) {
            const int m = m0 + ty * 4 + i, n = n0 + tx * 4 + j;
            if (MODE == 0) Cb[(size_t)m * PP + n] = f2bf(acc[i][j]);
            else Cf[(size_t)m * D + n] = res[(size_t)m * D + n] + acc[i][j];
        }
}

__device__ __forceinline__ float log_sigmoid(float x) { return fminf(x, 0.f) - log1pf(expf(-fabsf(x))); }
__global__ __launch_bounds__(128) void k_gla_naive(const bf16* proj, const float* wf, const float* bfv, const float* wb, const float* bb, float* o_dir) {
    const int combo = blockIdx.x, dir = combo & 1, h = (combo >> 1) & 3, b = combo >> 3;
    const int vc = threadIdx.x;
    const float* W = dir ? wb : wf; const float* Bv = dir ? bb : bfv;
    __shared__ float sa[16][64], sq[16][64], sk[16][64];
    float st[64];
#pragma unroll
    for (int d = 0; d < 64; ++d) st[d] = 0.f;
    float* outp = o_dir + (size_t)dir * T * 512;
    for (int s0 = 0; s0 < SEQ; s0 += 16) {
        __syncthreads();
        for (int e = threadIdx.x; e < 16 * 64; e += 128) {
            const int i = e >> 6, d = e & 63;
            const int pos = dir ? (SEQ - 1 - (s0 + i)) : (s0 + i);
            const size_t row = (size_t)(b * SEQ + pos) * PP;
            float z = Bv[h * 64 + d];
            for (int r = 0; r < 16; ++r) z += bf2f(proj[row + (dir ? C_LB : C_LF) + r]) * W[r * 256 + h * 64 + d];
            sa[i][d] = expf(log_sigmoid(z) * (1.f / 16.f));
            sq[i][d] = bf2f(proj[row + C_GQ + h * 64 + d]) * 0.125f;
            sk[i][d] = bf2f(proj[row + C_GK + h * 64 + d]);
        }
        __syncthreads();
        for (int i = 0; i < 16; ++i) {
            const int pos = dir ? (SEQ - 1 - (s0 + i)) : (s0 + i);
            const size_t tok = (size_t)(b * SEQ + pos);
            const float v = bf2f(proj[tok * PP + C_GV + h * 128 + vc]);
            float o = 0.f;
#pragma unroll
            for (int d = 0; d < 64; ++d) { st[d] = st[d] * sa[i][d] + sk[i][d] * v; o += sq[i][d] * st[d]; }
            outp[tok * 512 + h * 128 + vc] = o;
        }
    }
}
__global__ __launch_bounds__(256) void k_gla_post(const float* o_dir, const bf16* proj, const float* nw, bf16* mixed) {
    const int item = blockIdx.x * 4 + (threadIdx.x >> 6), lane = threadIdx.x & 63;
    const int tok = item >> 2, h = item & 3;
    const size_t off = (size_t)tok * 512 + h * 128;
    const float a0 = o_dir[off + lane] + o_dir[(size_t)T * 512 + off + lane], a1 = o_dir[off + 64 + lane] + o_dir[(size_t)T * 512 + off + 64 + lane];
    const float rstd = rsqrtf(wave_sum(a0 * a0 + a1 * a1) * (1.f / 128.f) + 1e-6f);
    const float g0 = bf2f(proj[(size_t)tok * PP + C_GG + h * 128 + lane]), g1 = bf2f(proj[(size_t)tok * PP + C_GG + h * 128 + 64 + lane]);
    mixed[(size_t)tok * D + h * 128 + lane] = f2bf(a0 * rstd * nw[lane] * (g0 / (1.f + expf(-g0))));
    mixed[(size_t)tok * D + h * 128 + 64 + lane] = f2bf(a1 * rstd * nw[64 + lane] * (g1 / (1.f + expf(-g1))));
}

__device__ __forceinline__ float rope_val(float x, int lane, int pos) {
    const float partner = __shfl_xor(x, 8);
    if (lane >= 16) return x;
    const int i = lane & 7;
    const float inv = (float)exp2(-(double)i * 0.125 * 18.931568569324174);
    const float ang = (float)pos * inv;
    const float c = cosf(ang), s = sinf(ang);
    return lane < 8 ? x * c - partner * s : x * c + partner * s;
}
__global__ __launch_bounds__(256) void k_attn_naive(const bf16* proj, bf16* mixed) {
    const int item = blockIdx.x * 4 + (threadIdx.x >> 6), lane = threadIdx.x & 63;
    const int tok = item >> 3, h = item & 7, b = tok / SEQ, s = tok % SEQ;
    const float q = rope_val(bf2f(proj[(size_t)tok * PP + C_AQ + h * 64 + lane]), lane, s) * 0.125f;
    float m = -1e30f, l = 0.f, o = 0.f;
    for (int p = 0; p < 3; ++p) {
        const int dil = p == 0 ? 1 : (p == 1 ? 4 : 16);
        for (int dl = -64; dl <= 64; ++dl) {
            const int ks = s + dil * dl;
            if (ks < 0 || ks >= SEQ) continue;
            const size_t kt = (size_t)(b * SEQ + ks);
            const float k = rope_val(bf2f(proj[kt * PP + C_AK + h * 64 + lane]), lane, ks);
            const float sc = wave_sum(q * k);
            const float mn = fmaxf(m, sc), al = expf(m - mn), pe = expf(sc - mn);
            l = l * al + pe; o = o * al + pe * bf2f(proj[kt * PP + C_AV + h * 64 + lane]); m = mn;
        }
    }
    mixed[(size_t)tok * D + 512 + h * 64 + lane] = f2bf(o / l);
}

__global__ __launch_bounds__(256) void k_router(const float* hbuf, const float* nw, const float* wg, const float* bg, const float* we, const float* be,
                                                bf16* u2, unsigned* cnt, int* list, float* wgt) {
    const int row = blockIdx.x * 4 + (threadIdx.x >> 6), lane = threadIdx.x & 63;
    const float4* xr = (const float4*)(hbuf + (size_t)row * D) + lane;
    float u[16]; float s = 0.f;
#pragma unroll
    for (int j = 0; j < 4; ++j) { const float4 v = xr[64 * j]; u[4 * j] = v.x; u[4 * j + 1] = v.y; u[4 * j + 2] = v.z; u[4 * j + 3] = v.w; s += v.x * v.x + v.y * v.y + v.z * v.z + v.w * v.w; }
    const float rstd = rsqrtf(wave_sum(s) * (1.f / D) + 1e-6f);
#pragma unroll
    for (int j = 0; j < 4; ++j) {
        const float4 ww = ((const float4*)nw)[lane + 64 * j];
        u[4 * j] *= rstd * ww.x; u[4 * j + 1] *= rstd * ww.y; u[4 * j + 2] *= rstd * ww.z; u[4 * j + 3] *= rstd * ww.w;
        bf16* o = u2 + (size_t)row * D + (lane + 64 * j) * 4;
#pragma unroll
        for (int c = 0; c < 4; ++c) o[c] = f2bf(u[4 * j + c]);
    }
    float gl[4];
#pragma unroll
    for (int g = 0; g < 4; ++g) { float p = 0.f;
#pragma unroll
        for (int j = 0; j < 4; ++j)
#pragma unroll
            for (int c = 0; c < 4; ++c) p += u[4 * j + c] * wg[(size_t)((lane + 64 * j) * 4 + c) * 4 + g];
        gl[g] = wave_sum(p) + bg[g]; }
    int gs = 0; float gm = gl[0];
#pragma unroll
    for (int g = 1; g < 4; ++g) if (gl[g] > gm) { gm = gl[g]; gs = g; }
    float gz = 0.f;
#pragma unroll
    for (int g = 0; g < 4; ++g) gz += expf(gl[g] - gm);
    const float gw = 1.f / gz;
    float el[8];
#pragma unroll
    for (int e = 0; e < 8; ++e) { float p = 0.f;
#pragma unroll
        for (int j = 0; j < 4; ++j)
#pragma unroll
            for (int c = 0; c < 4; ++c) p += u[4 * j + c] * we[((size_t)gs * D + (lane + 64 * j) * 4 + c) * 8 + e];
        el[e] = wave_sum(p) + be[gs * 8 + e]; }
    int i0 = 0; float v0 = el[0];
#pragma unroll
    for (int e = 1; e < 8; ++e) if (el[e] > v0) { v0 = el[e]; i0 = e; }
    int i1 = -1; float v1 = -3.0e38f;
#pragma unroll
    for (int e = 0; e < 8; ++e) if (e != i0 && el[e] > v1) { v1 = el[e]; i1 = e; }
    const float e1 = expf(v1 - v0), w0 = gw / (1.f + e1), w1 = gw * e1 / (1.f + e1);
    if (lane == 0) {
        const int ex0 = gs * 8 + i0, ex1 = gs * 8 + i1;
        const unsigned s0 = atomicAdd(cnt + ex0, 1u), s1 = atomicAdd(cnt + ex1, 1u);
        list[(size_t)ex0 * T + s0] = row * 2; list[(size_t)ex1 * T + s1] = row * 2 + 1;
        wgt[row * 2] = w0; wgt[row * 2 + 1] = w1;
    }
}

__global__ __launch_bounds__(256) void k_moe_naive(const bf16* u2, const unsigned* cnt, const int* list, const float* wgt,
                                                   const float* Wg, const float* Wu, const float* Wd, bf16* ybuf) {
    const int e = blockIdx.y, r0 = blockIdx.x * 8;
    const int n = (int)cnt[e];
    if (r0 >= n) return;
    __shared__ float X[8][1024];
    __shared__ float Aact[8][512];
    __shared__ int asg[8];
    if (threadIdx.x < 8) asg[threadIdx.x] = (r0 + threadIdx.x < n) ? list[(size_t)e * T + r0 + threadIdx.x] : -1;
    __syncthreads();
    for (int i = threadIdx.x; i < 8 * 1024; i += 256) { const int r = i >> 10, k = i & 1023; X[r][k] = asg[r] >= 0 ? bf2f(u2[(size_t)(asg[r] >> 1) * D + k]) : 0.f; }
    __syncthreads();
    const float* wg = Wg + (size_t)e * 1024 * 512; const float* wu = Wu + (size_t)e * 1024 * 512; const float* wd = Wd + (size_t)e * 512 * 1024;
    for (int cc = 0; cc < 2; ++cc) {
        const int c = threadIdx.x + 256 * cc;
        float g[8], u[8];
#pragma unroll
        for (int r = 0; r < 8; ++r) { g[r] = 0.f; u[r] = 0.f; }
        for (int k = 0; k < 1024; ++k) { const float a = wg[(size_t)k * 512 + c], bq = wu[(size_t)k * 512 + c];
#pragma unroll
            for (int r = 0; r < 8; ++r) { g[r] += X[r][k] * a; u[r] += X[r][k] * bq; } }
#pragma unroll
        for (int r = 0; r < 8; ++r) Aact[r][c] = bf2f(f2bf(g[r] / (1.f + expf(-g[r])) * u[r]));
    }
    __syncthreads();
    for (int cc = 0; cc < 4; ++cc) {
        const int c = threadIdx.x + 256 * cc;
        float y[8];
#pragma unroll
        for (int r = 0; r < 8; ++r) y[r] = 0.f;
        for (int k = 0; k < 512; ++k) { const float a = wd[(size_t)k * 1024 + c];
#pragma unroll
            for (int r = 0; r < 8; ++r) y[r] += Aact[r][k] * a; }
#pragma unroll
        for (int r = 0; r < 8; ++r) if (asg[r] >= 0) ybuf[(size_t)asg[r] * D + c] = f2bf(y[r] * wgt[asg[r]]);
    }
}

__global__ __launch_bounds__(256) void k_final(float* hbuf, const bf16* ybuf, const float* w) {
    const int row = blockIdx.x * 4 + (threadIdx.x >> 6), lane = threadIdx.x & 63;
    float4* xr = (float4*)(hbuf + (size_t)row * D) + lane;
    float u[16]; float s = 0.f;
#pragma unroll
    for (int j = 0; j < 4; ++j) { const float4 v = xr[64 * j]; u[4 * j] = v.x; u[4 * j + 1] = v.y; u[4 * j + 2] = v.z; u[4 * j + 3] = v.w; }
#pragma unroll
    for (int j = 0; j < 4; ++j)
#pragma unroll
        for (int c = 0; c < 4; ++c) {
            const size_t col = (size_t)(lane + 64 * j) * 4 + c;
            u[4 * j + c] += bf2f(ybuf[(size_t)(row * 2) * D + col]) + bf2f(ybuf[(size_t)(row * 2 + 1) * D + col]);
            s += u[4 * j + c] * u[4 * j + c];
        }
    const float rstd = rsqrtf(wave_sum(s) * (1.f / D) + 1e-6f);
#pragma unroll
    for (int j = 0; j < 4; ++j) { const float4 ww = ((const float4*)w)[lane + 64 * j];
        xr[64 * j] = make_float4(u[4 * j] * rstd * ww.x, u[4 * j + 1] * rstd * ww.y, u[4 * j + 2] * rstd * ww.z, u[4 * j + 3] * rstd * ww.w); }
}


namespace pg8 {
#define PG8_LAS __attribute__((address_space(3)))
typedef unsigned short bf16_t;
typedef short bf16x8 __attribute__((ext_vector_type(8)));
typedef float f32x4 __attribute__((ext_vector_type(4)));
typedef unsigned u32x4 __attribute__((ext_vector_type(4)));
constexpr int BM = 256, BK = 64, HALF = 128, HTB = HALF * BK * 2  , STAGE_BYTES = 8 * HTB, NXCD = 8, WGM = 8;

__host__ __device__ __forceinline__ int lds_byte(int r, int c) { const int st = (r >> 4) * 2 + (c >> 5), rr = r & 15, cc = c & 31, ob = rr * 64 + cc * 2; return st * 1024 + (ob ^ (((ob >> 9) & 1) << 5)); }
__host__ __device__ __forceinline__ void stage_rc(int b, int& R, int& C) { const int st = b / 1024, sb = b % 1024, swz = sb ^ (((sb >> 9) & 1) << 5); R = (st >> 1) * 16 + swz / 64; C = (st & 1) * 32 + (swz % 64) / 2; }
__host__ __device__ __forceinline__ int perm32(int rho) { const int n = rho >> 4, i = rho & 15; return 8 * (i >> 2) + 4 * n + (i & 3); }

struct Unit { int pm, pn, aux; };

struct StaticOrder {
    const char* A; const char* Bt; int K, nM, nN, nwg, G, c;
    __device__ void init(const void* A_, const void* Bt_, int M, int N, int K_, int G_, int c_) { A = (const char*)A_; Bt = (const char*)Bt_; K = K_; nM = M / BM; nN = N / BM; nwg = nM * nN; G = G_; c = c_; }
    __device__ bool next(int i, Unit& u) const {
        const long L = (long)i * G + c; if (L >= nwg) return false;
        int wgid = (int)L; { const int q = nwg / NXCD, r = nwg % NXCD, xcd = wgid % NXCD, off = wgid / NXCD; wgid = (xcd < r ? xcd * (q + 1) : r * (q + 1) + (xcd - r) * q) + off; }
        const int nig = WGM * nN, gid = wgid / nig, fm = gid * WGM, gsz = (nM - fm) < WGM ? (nM - fm) : WGM;
        u.pm = fm + ((wgid % nig) % gsz); u.pn = (wgid % nig) / gsz; u.aux = 0; return true;
    }
    __device__ __forceinline__ const char* a_base(const Unit& u) const { return A + (size_t)u.pm * BM * K * 2; }
    __device__ __forceinline__ const char* b_base(const Unit& u) const { return Bt + (size_t)u.pn * BM * K * 2; }
    __device__ __forceinline__ unsigned a_off(const Unit&, int r) const { return (unsigned)(r * K * 2); }
};
template <bool GATHER> struct MoeOrder {
    const char* A; const char* Bt; size_t estride; int K, total, G, c; const PG8_LAS int* tab; const unsigned* cnt; const int* list;
    __device__ bool next(int i, Unit& u) const {
        const long L = (long)i * G + c; if (L >= total) return false;
        int id = (int)L; { const int q = total / NXCD, r = total % NXCD, xcd = id % NXCD, off = id / NXCD; id = (xcd < r ? xcd * (q + 1) : r * (q + 1) + (xcd - r) * q) + off; }
        u.pm = id >> 2; u.pn = id & 3; u.aux = tab[u.pm]; return true;
    }
    __device__ __forceinline__ const char* a_base(const Unit& u) const { return GATHER ? A : A + (size_t)u.pm * BM * K * 2; }
    __device__ __forceinline__ const char* b_base(const Unit& u) const { return Bt + (size_t)(u.aux >> 8) * estride + (size_t)u.pn * BM * K * 2; }
    __device__ __forceinline__ unsigned a_off(const Unit& u, int r) const {
        if (!GATHER) return (unsigned)(r * K * 2);
        const int e = u.aux >> 8, idx = (u.aux & 255) * 256 + r; const int n = (int)cnt[e];
        const int tok = idx < n ? (list[(size_t)e * 16384 + idx] >> 1) : 0;
        return (unsigned)tok * (unsigned)(K * 2);
    }
};

__device__ __forceinline__ unsigned cvt_pk_bf16(float lo, float hi) { unsigned r; asm volatile("v_cvt_pk_bf16_f32 %0, %1, %2" : "=v"(r) : "v"(lo), "v"(hi)); return r; }

struct EpiBf16 {
    static constexpr bool PERM = true, AFTER_DRAIN = false;
    bf16_t* O; int ldc;
    __device__ __forceinline__ void operator()(const f32x4 (&acc)[2][2][4][2], const Unit& u, int wr, int wc, int fr, int fq) const {
        const int row0 = u.pm * BM + wr * 64 + fr, col0 = u.pn * BM + wc * 32 + 8 * fq;
#pragma unroll
        for (int ai = 0; ai < 2; ++ai)
#pragma unroll
            for (int m = 0; m < 4; ++m) { bf16_t* rowp = O + (size_t)(row0 + ai * HALF + m * 16) * ldc + col0;
#pragma unroll
                for (int bj = 0; bj < 2; ++bj) { const f32x4 v0 = acc[ai][bj][m][0], v1 = acc[ai][bj][m][1];
                    u32x4 w; w.x = cvt_pk_bf16(v0[0], v0[1]); w.y = cvt_pk_bf16(v0[2], v0[3]); w.z = cvt_pk_bf16(v1[0], v1[1]); w.w = cvt_pk_bf16(v1[2], v1[3]);
                    *(u32x4*)(rowp + bj * HALF) = w; } }
    }
};
struct EpiF32Res {
    static constexpr bool PERM = false, AFTER_DRAIN = false;
    float* C; const float* res; int ldc;
    __device__ __forceinline__ void operator()(const f32x4 (&acc)[2][2][4][2], const Unit& u, int wr, int wc, int fr, int fq) const {
        const int row0 = u.pm * BM + wr * 64 + fr, col0 = u.pn * BM + wc * 32 + 4 * fq;
#pragma unroll
        for (int ai = 0; ai < 2; ++ai) { f32x4 rv[4][2][2];
#pragma unroll
            for (int m = 0; m < 4; ++m) { const size_t off = (size_t)(row0 + ai * HALF + m * 16) * ldc + col0;
#pragma unroll
                for (int bj = 0; bj < 2; ++bj)
#pragma unroll
                    for (int n = 0; n < 2; ++n) rv[m][bj][n] = __builtin_nontemporal_load((const f32x4*)(res + off + bj * HALF + n * 16)); }
#pragma unroll
            for (int m = 0; m < 4; ++m) { const size_t off = (size_t)(row0 + ai * HALF + m * 16) * ldc + col0;
#pragma unroll
                for (int bj = 0; bj < 2; ++bj)
#pragma unroll
                    for (int n = 0; n < 2; ++n) *(f32x4*)(C + off + bj * HALF + n * 16) = rv[m][bj][n] + acc[ai][bj][m][n]; }
            asm volatile("" ::: "memory"); }
    }
};
__device__ __forceinline__ float silu_mul(float g, float u) { return g * u * __builtin_amdgcn_rcpf(1.0f + __builtin_amdgcn_exp2f(-1.4426950408889634f * g)); }
struct EpiGateUp {
    static constexpr bool PERM = true, AFTER_DRAIN = false;
    bf16_t* ACT;
    __device__ __forceinline__ void operator()(const f32x4 (&acc)[2][2][4][2], const Unit& u, int wr, int wc, int fr, int fq) const {
        const int row0 = u.pm * BM + wr * 64 + fr, col0 = u.pn * HALF + wc * 32 + 8 * fq;
#pragma unroll
        for (int ai = 0; ai < 2; ++ai)
#pragma unroll
            for (int m = 0; m < 4; ++m) { bf16_t* rowp = ACT + (size_t)(row0 + ai * HALF + m * 16) * 512 + col0;
                const f32x4 g0 = acc[ai][0][m][0], g1 = acc[ai][0][m][1], u0 = acc[ai][1][m][0], u1 = acc[ai][1][m][1];
                u32x4 w; w.x = cvt_pk_bf16(silu_mul(g0[0], u0[0]), silu_mul(g0[1], u0[1])); w.y = cvt_pk_bf16(silu_mul(g0[2], u0[2]), silu_mul(g0[3], u0[3]));
                w.z = cvt_pk_bf16(silu_mul(g1[0], u1[0]), silu_mul(g1[1], u1[1])); w.w = cvt_pk_bf16(silu_mul(g1[2], u1[2]), silu_mul(g1[3], u1[3]));
                *(u32x4*)rowp = w; }
    }
};
struct EpiDown {
    static constexpr bool PERM = true, AFTER_DRAIN = false;
    bf16_t* Y; const int* list; const unsigned* cnt; const float* wgt;
    __device__ __forceinline__ void operator()(const f32x4 (&acc)[2][2][4][2], const Unit& u, int wr, int wc, int fr, int fq) const {
        const int e = u.aux >> 8, rt = u.aux & 255, n = (int)cnt[e];
        const int r0 = rt * BM + wr * 64 + fr, col0 = u.pn * BM + wc * 32 + 8 * fq;
#pragma unroll
        for (int ai = 0; ai < 2; ++ai)
#pragma unroll
            for (int m = 0; m < 4; ++m) { const int r = r0 + ai * HALF + m * 16;
                if (r < n) { const int a = list[(size_t)e * 16384 + r]; const float w = wgt[a]; bf16_t* rowp = Y + (size_t)a * 1024 + col0;
#pragma unroll
                    for (int bj = 0; bj < 2; ++bj) { const f32x4 v0 = acc[ai][bj][m][0] * w, v1 = acc[ai][bj][m][1] * w;
                        u32x4 o; o.x = cvt_pk_bf16(v0[0], v0[1]); o.y = cvt_pk_bf16(v0[2], v0[3]); o.z = cvt_pk_bf16(v1[0], v1[1]); o.w = cvt_pk_bf16(v1[2], v1[3]);
                        *(u32x4*)(rowp + bj * HALF) = o; } } }
    }
};

template <class Epi, class Sched, bool GATHER, bool ALIGN_EPI>
__device__ __forceinline__ void gemm_phase(PG8_LAS unsigned char* lds, const int K, const Sched& S, const Epi& E) {
    const int tid = threadIdx.x, wid = __builtin_amdgcn_readfirstlane(tid >> 6), lane = tid & 63, wr = wid >> 2, wc = wid & 3, fr = lane & 15, fq = lane >> 4;
    const int nt = K / BK;
    int RA[2], CA[2]; unsigned voffB[2];
#pragma unroll
    for (int i = 0; i < 2; ++i) { int R, C; stage_rc(tid * 16 + i * 8192, R, C); const int Rb = Epi::PERM ? ((R & ~31) + perm32(R & 31)) : R;
        RA[i] = R; CA[i] = C * 2; voffB[i] = (unsigned)(Rb * K + C) * 2u; }
    const size_t kstep = (size_t)(BK * 2);
    const size_t hstep = (size_t)HALF * K * 2;
    const unsigned ldsw = (unsigned)wid * 1024u;
    const int aoff = lds_byte(wr * 64 + fr, fq * 8), boff = lds_byte(wc * 32 + fr, fq * 8);
#define PG8_SA(b, h) (((b) * 2 + (h)) * HTB)
#define PG8_SB(b, h) ((4 + (b) * 2 + (h)) * HTB)
#define PG8_STAGE(bufoff, gbase, voff) do { _Pragma("unroll") for (int _i = 0; _i < 2; ++_i) \
        __builtin_amdgcn_global_load_lds((const unsigned*)((const char*)(gbase) + (voff)[_i]), (PG8_LAS unsigned*)(lds + (bufoff) + ldsw + _i * 8192), 16, 0, 0); } while (0)
#define PG8_LDA(dst, b, h) do { _Pragma("unroll") for (int m = 0; m < 4; ++m) _Pragma("unroll") for (int k = 0; k < 2; ++k) dst[m][k] = *(const PG8_LAS bf16x8*)(lds + PG8_SA(b, h) + aoff + m * 2048 + k * 1024); } while (0)
#define PG8_LDB(dst, b, h) do { _Pragma("unroll") for (int n = 0; n < 2; ++n) _Pragma("unroll") for (int k = 0; k < 2; ++k) dst[n][k] = *(const PG8_LAS bf16x8*)(lds + PG8_SB(b, h) + boff + n * 2048 + k * 1024); } while (0)
#define PG8_MMA(ai, bj, At, Bt) do { __builtin_amdgcn_s_setprio(1); _Pragma("unroll") for (int m = 0; m < 4; ++m) _Pragma("unroll") for (int n = 0; n < 2; ++n) _Pragma("unroll") for (int k = 0; k < 2; ++k) \
        acc[ai][bj][m][n] = __builtin_amdgcn_mfma_f32_16x16x32_bf16(Bt[n][k], At[m][k], acc[ai][bj][m][n], 0, 0, 0); __builtin_amdgcn_s_setprio(0); } while (0)
#define PG8_WAIT_V(n) asm volatile("s_waitcnt vmcnt(" #n ")" ::: "memory")
#define PG8_WAIT_L(n) asm volatile("s_waitcnt lgkmcnt(" #n ")" ::: "memory")
#define PG8_BAR __builtin_amdgcn_s_barrier()
#define PG8_SCHED __builtin_amdgcn_sched_barrier(0)
#define PG8_AOFFS(dst, u) do { _Pragma("unroll") for (int _h = 0; _h < 2; ++_h) _Pragma("unroll") for (int _i = 0; _i < 2; ++_i) dst[_h][_i] = S.a_off(u, RA[_i] + HALF * _h) + (unsigned)CA[_i]; } while (0)
    Unit cur, nxt; int ui = 0;
    if (!S.next(0, cur)) return;
    f32x4 acc[2][2][4][2];
#pragma unroll
    for (int a = 0; a < 2; ++a)
#pragma unroll
        for (int b = 0; b < 2; ++b)
#pragma unroll
            for (int m = 0; m < 4; ++m)
#pragma unroll
                for (int n = 0; n < 2; ++n) acc[a][b][m][n] = (f32x4){0.f, 0.f, 0.f, 0.f};
    bf16x8 At[4][2], B0[2][2], B1[2][2];
    unsigned vA[2][2], vN[2][2];
    PG8_AOFFS(vA, cur);
    const char* cA = S.a_base(cur); const char* cB = S.b_base(cur);
    PG8_STAGE(PG8_SB(0, 0), cB, voffB); PG8_STAGE(PG8_SB(0, 1), cB + hstep, voffB); PG8_STAGE(PG8_SA(0, 0), cA, vA[0]); PG8_STAGE(PG8_SA(0, 1), cA, vA[1]);
    if (wr == 1) PG8_BAR;
    PG8_WAIT_V(2); PG8_BAR;
    PG8_STAGE(PG8_SB(1, 0), cB + kstep, voffB); PG8_STAGE(PG8_SA(1, 0), cA + kstep, vA[0]); PG8_STAGE(PG8_SB(1, 1), cB + hstep + kstep, voffB);
    PG8_WAIT_V(6); PG8_BAR;
    for (;;) {
        const bool has_next = S.next(ui + 1, nxt);
        const char* nA = cA; const char* nB = cB;
        if (has_next) { nA = S.a_base(nxt); nB = S.b_base(nxt); }
        if (GATHER) { if (has_next) { PG8_AOFFS(vN, nxt); } else {
#pragma unroll
            for (int h = 0; h < 2; ++h)
#pragma unroll
                for (int i = 0; i < 2; ++i) vN[h][i] = vA[h][i]; } }
        for (int t = 0; t < nt; t += 2) {
            const bool last = (t == nt - 2);
            const char* a1 = cA + (size_t)(t + 1) * kstep;
            const char* a2 = last ? nA : cA + (size_t)(t + 2) * kstep; const char* b2 = last ? nB : cB + (size_t)(t + 2) * kstep;
            const char* a3 = a2 + kstep; const char* b3 = b2 + kstep;
            unsigned vS[2][2];
#pragma unroll
            for (int h = 0; h < 2; ++h)
#pragma unroll
                for (int i = 0; i < 2; ++i) vS[h][i] = (GATHER && last) ? vN[h][i] : vA[h][i];
            PG8_LDB(B0, 0, 0); PG8_LDB(B1, 0, 1); PG8_SCHED; PG8_LDA(At, 0, 0); PG8_STAGE(PG8_SA(1, 1), a1, vA[1]);
            PG8_WAIT_V(8); PG8_WAIT_L(0); PG8_BAR; PG8_MMA(0, 0, At, B0); PG8_MMA(0, 1, At, B1); PG8_BAR; PG8_SCHED;
            PG8_LDA(At, 0, 1); PG8_STAGE(PG8_SB(0, 0), b2, voffB); PG8_STAGE(PG8_SB(0, 1), b2 + hstep, voffB); PG8_STAGE(PG8_SA(0, 0), a2, vS[0]);
            PG8_WAIT_V(8); PG8_WAIT_L(0); PG8_BAR; PG8_MMA(1, 0, At, B0); PG8_MMA(1, 1, At, B1); PG8_BAR; PG8_SCHED;
            PG8_LDB(B0, 1, 0); PG8_LDB(B1, 1, 1); PG8_SCHED; PG8_LDA(At, 1, 0); PG8_STAGE(PG8_SA(0, 1), a2, vS[1]);
            PG8_WAIT_V(8); PG8_WAIT_L(0); PG8_BAR; PG8_MMA(0, 0, At, B0); PG8_MMA(0, 1, At, B1); PG8_BAR; PG8_SCHED;
            PG8_LDA(At, 1, 1); PG8_STAGE(PG8_SB(1, 0), b3, voffB); PG8_STAGE(PG8_SB(1, 1), b3 + hstep, voffB); PG8_STAGE(PG8_SA(1, 0), a3, vS[0]);
            PG8_WAIT_V(8); PG8_WAIT_L(0); PG8_BAR; PG8_MMA(1, 0, At, B0); PG8_MMA(1, 1, At, B1); PG8_BAR; PG8_SCHED;
        }
        if constexpr (ALIGN_EPI) { if (wr == 0) PG8_BAR; }
        E(acc, cur, wr, wc, fr, fq);
        if (!has_next) break;
#pragma unroll
        for (int a = 0; a < 2; ++a)
#pragma unroll
            for (int b = 0; b < 2; ++b)
#pragma unroll
                for (int m = 0; m < 4; ++m)
#pragma unroll
                    for (int n = 0; n < 2; ++n) acc[a][b][m][n] = (f32x4){0.f, 0.f, 0.f, 0.f};
        cur = nxt; cA = nA; cB = nB; ++ui;
        if (GATHER) {
#pragma unroll
            for (int h = 0; h < 2; ++h)
#pragma unroll
                for (int i = 0; i < 2; ++i) vA[h][i] = vN[h][i]; }
        if constexpr (ALIGN_EPI) { if (wr == 1) PG8_BAR; }
    }
    PG8_WAIT_V(0);
    if constexpr (!ALIGN_EPI) { if (wr == 0) PG8_BAR; }
    PG8_BAR;
#undef PG8_SA
#undef PG8_SB
#undef PG8_STAGE
#undef PG8_LDA
#undef PG8_LDB
#undef PG8_MMA
#undef PG8_WAIT_V
#undef PG8_WAIT_L
#undef PG8_BAR
#undef PG8_SCHED
#undef PG8_AOFFS
}
}

constexpr int NWAVES = 8;
constexpr size_t WS_WIN = 1 * MiB;
constexpr size_t WS_WOUT = 8 * MiB;
constexpr size_t WS_WGU = 42 * MiB;
constexpr size_t WS_WD = 106 * MiB;
constexpr size_t WS_ACT = 146 * MiB;
constexpr size_t WS_ROPE = 253 * MiB;
constexpr size_t WS_DEC = 254 * MiB;
constexpr int CW_BAR = 4096;
constexpr int RING_OFF = 0, RING_BYTES = 131072;
constexpr int TAB_OFF = 147456, MISC_OFF = TAB_OFF + 1024, LDS_BYTES = MISC_OFF + 256;

#define GAS __attribute__((address_space(1)))
#define LAS __attribute__((address_space(3)))
typedef unsigned v4u __attribute__((ext_vector_type(4)));
typedef unsigned v2u __attribute__((ext_vector_type(2)));
typedef float f32x4 __attribute__((ext_vector_type(4)));
typedef short bf16x8 __attribute__((ext_vector_type(8)));
typedef GAS unsigned gu32;
#define RLX_AGENT __ATOMIC_RELAXED, __HIP_MEMORY_SCOPE_AGENT
#define LDS_WAIT() asm volatile("s_waitcnt lgkmcnt(0)" ::: "memory")
#define VM_WAIT() asm volatile("s_waitcnt vmcnt(0)" ::: "memory")
__device__ __forceinline__ unsigned pk2(float lo, float hi) { return (unsigned)f2bf(lo) | ((unsigned)f2bf(hi) << 16); }

#define XB_TMO      128
#define XB_XCNT(j)  (256  + 64 * (j))
#define XB_XSUB(j)  (1280 + 64 * (j))
#define XB_XGEN(j)  (2304 + 64 * (j))
#define XB_TOP      3328
#define XB_TOPGEN   3392
#define XCD_BAR_WORDS 3456
#define XB_SPIN_CAP (1u << 18)

__device__ __forceinline__ unsigned xb_ld(unsigned* p)              { return __hip_atomic_load(p, __ATOMIC_RELAXED, __HIP_MEMORY_SCOPE_AGENT); }
__device__ __forceinline__ unsigned xb_add(unsigned* p, unsigned v) { return __hip_atomic_fetch_add(p, v, __ATOMIC_RELAXED, __HIP_MEMORY_SCOPE_AGENT); }
__device__ __forceinline__ unsigned xb_xcc_id() { return (unsigned)__builtin_amdgcn_s_getreg((3 << 11) | 20) & 0xFu; }
#define XB_SPIN(cond, bar) do { unsigned _sp = 0; while (cond) { __builtin_amdgcn_s_sleep(1); \
    if ((++_sp & 255u) == 0u) { if (xb_ld(&(bar)[XB_TMO])) break; if (_sp > XB_SPIN_CAP) { atomicAdd(&(bar)[XB_TMO], 1u); break; } } } } while (0)

struct XcdBarrier {
    unsigned* bar; unsigned x;
    volatile LAS unsigned* st;
};
__device__ __forceinline__ XcdBarrier xcd_barrier_post(unsigned* bar, volatile LAS unsigned* st) {
    XcdBarrier b; b.bar = bar; b.x = xb_xcc_id(); b.st = st;
    if (threadIdx.x == 0) (void)xb_add(&bar[XB_XCNT(b.x)], 1u);
    return b;
}
__device__ __forceinline__ void xcd_barrier_complete(unsigned* bar, unsigned x, unsigned& nloc, unsigned& nx) {
    const unsigned G = gridDim.x * gridDim.y * gridDim.z;
    unsigned sum, cnt, mine, sp = 0u;
    for (;;) {
        sum = 0u; cnt = 0u; mine = 0u;
#pragma unroll
        for (unsigned j = 0; j < 16; ++j) { const unsigned c = xb_ld(&bar[XB_XCNT(j)]); sum += c; cnt += (c > 0u) ? 1u : 0u; mine = (j == x) ? c : mine; }
        if (sum == G) break;
        __builtin_amdgcn_s_sleep(1);
        if ((++sp & 255u) == 0u) { if (xb_ld(&bar[XB_TMO])) break; if (sp > XB_SPIN_CAP) { atomicAdd(&bar[XB_TMO], 1u); break; } }
    }
    nloc = mine > 0u ? mine : 1u; nx = cnt > 0u ? cnt : 1u;
}
__device__ __forceinline__ void xcd_barrier(const XcdBarrier& b) {
    asm volatile("s_waitcnt vmcnt(0)" ::: "memory");
    __syncthreads();
    if (threadIdx.x == 0) {
        unsigned* bar = b.bar;
        __builtin_amdgcn_s_waitcnt(0);
        unsigned nloc = b.st[0], nx = b.st[1];
        if (nloc == 0u) { xcd_barrier_complete(bar, b.x, nloc, nx); b.st[0] = nloc; b.st[1] = nx; }
        const unsigned old = xb_add(&bar[XB_XSUB(b.x)], 1u);
        const unsigned gen = old / nloc;
        if (old + 1u == (gen + 1u) * nloc) {
            __builtin_amdgcn_fence(__ATOMIC_RELEASE, "agent");
            asm volatile("s_waitcnt vmcnt(0)" ::: "memory");
            const unsigned og = xb_add(&bar[XB_TOP], 1u);
            const unsigned tg = og / nx;
            if (og + 1u == (tg + 1u) * nx) xb_add(&bar[XB_TOPGEN], 1u);
            else XB_SPIN(xb_ld(&bar[XB_TOPGEN]) == tg, bar);
            __builtin_amdgcn_fence(__ATOMIC_ACQUIRE, "agent");
            xb_add(&bar[XB_XGEN(b.x)], 1u);
            asm volatile("s_waitcnt vmcnt(0)" ::: "memory");
        } else {
            XB_SPIN(xb_ld(&bar[XB_XGEN(b.x)]) == gen, bar);
            __builtin_amdgcn_fence(__ATOMIC_ACQUIRE, "agent");
            asm volatile("s_waitcnt vmcnt(0)" ::: "memory");
        }
    }
    __syncthreads();
}

struct Frame {
    LAS unsigned char* lds;
    volatile LAS unsigned* MISC;
    gu32* ctl;
    int tid, lane, wave;
    int vcu, G;
    const float* in[18]; float* out; unsigned char* ws;
};

__device__ __forceinline__ void transpose_item(const float* W, int ldw, int k0, int n0, bf16* WT, int ldt, int row0, LAS float* scr, int lane) {
#pragma unroll 8
    for (int i = 0; i < 32; ++i) { const int kk = 2 * i + (lane >> 5); scr[kk * 33 + (lane & 31)] = W[(size_t)(k0 + kk) * ldw + n0 + (lane & 31)]; }
    LDS_WAIT(); asm volatile("" ::: "memory");
    const int c = lane & 7;
#pragma unroll
    for (int j = 0; j < 4; ++j) { const int n = (lane >> 3) + 8 * j; const LAS float* s = scr + (8 * c) * 33 + n;
        v4u o; o.x = pk2(s[0 * 33], s[1 * 33]); o.y = pk2(s[2 * 33], s[3 * 33]); o.z = pk2(s[4 * 33], s[5 * 33]); o.w = pk2(s[6 * 33], s[7 * 33]);
        *(GAS v4u*)(WT + (size_t)(row0 + n) * ldt + k0 + 8 * c) = o; }
    LDS_WAIT(); asm volatile("" ::: "memory");
}
__device__ __forceinline__ void rms_row_to_bf16(const float* xrow, const float* w, bf16* orow, int lane) {
    const GAS f32x4* xr = (const GAS f32x4*)xrow + lane;
    f32x4 v[4]; float s = 0.f;
#pragma unroll
    for (int j = 0; j < 4; ++j) { v[j] = xr[64 * j]; s += (v[j].x * v[j].x + v[j].y * v[j].y) + (v[j].z * v[j].z + v[j].w * v[j].w); }
    const float rstd = rsqrtf(wave_sum(s) * (1.f / D) + 1e-6f);
    GAS v2u* o8 = (GAS v2u*)orow + lane;
#pragma unroll
    for (int j = 0; j < 4; ++j) { const f32x4 ww = ((const GAS f32x4*)w)[lane + 64 * j]; v2u o; o.x = pk2(v[j].x * rstd * ww.x, v[j].y * rstd * ww.y); o.y = pk2(v[j].z * rstd * ww.z, v[j].w * rstd * ww.w); o8[64 * j] = o; }
}

__device__ __forceinline__ void p0_prologue(Frame& F) {
    LAS float* scr = (LAS float*)(F.lds + RING_OFF + F.wave * 16384);
    const int gw = F.vcu * NWAVES + F.wave, NGW = F.G * NWAVES;
    bf16* WIN = (bf16*)(F.ws + WS_WIN); bf16* WOUT = (bf16*)(F.ws + WS_WOUT);
    constexpr int I_IN = 16 * 97, I_OUT = 16 * 32;
    for (int it = gw; it < I_IN + I_OUT; it += NGW) {
        if (it < I_IN) { const int kb = it / 97, nb = it % 97; const int n0 = nb * 32;
            const int src = n0 < 1536 ? n0 : (n0 < 3072 ? n0 + 32 : n0 - 1536);
            transpose_item(F.in[2], INW, kb * 64, src, WIN, D, n0, scr, F.lane); }
        else { const int r = it - I_IN, kb = r / 32, nb = r % 32; transpose_item(F.in[8], D, kb * 64, nb * 32, WOUT, D, nb * 32, scr, F.lane); }
    }
    { GAS v4u* z = (GAS v4u*)(WIN + (size_t)INW * D); const int n16 = (PP - INW) * D * 2 / 16;
      for (int i = blockIdx.x * 512 + F.tid; i < n16; i += F.G * 512) z[i] = (v4u){0u, 0u, 0u, 0u}; }
    { float* rope = (float*)(F.ws + WS_ROPE);
      for (int i = blockIdx.x * 512 + F.tid; i < SEQ * 8; i += F.G * 512) { const int pos = i >> 3, j = i & 7;
          const double inv = exp2(-(double)j * 0.125 * 18.931568569324174);
          double r = (double)pos * inv * 0.15915494309189535; r -= floor(r);
          const float a = (float)(r * 6.283185307179586);
          rope[pos * 16 + j] = cosf(a); rope[pos * 16 + 8 + j] = sinf(a); } }
    bf16* U = (bf16*)(F.ws + WS_U);
    for (int m = gw; m < T; m += NGW) rms_row_to_bf16(F.in[0] + (size_t)m * D, F.in[1], U + (size_t)m * D, F.lane);
}

__device__ __forceinline__ void p6_router(Frame& F) {
    LAS float* WGt = (LAS float*)(F.lds);
    LAS float* WEt = (LAS float*)(F.lds + 16384);
    LAS unsigned* hist = (LAS unsigned*)(F.lds + TAB_OFF);
    LAS unsigned* base = hist + 32;
    LAS unsigned* sel = hist + 64;
    for (int k = F.tid; k < 1024; k += 512) { const f32x4 w = ((const GAS f32x4*)F.in[10])[k]; WGt[k] = w.x; WGt[1024 + k] = w.y; WGt[2048 + k] = w.z; WGt[3072 + k] = w.w; }
    for (int i = F.tid; i < 4096; i += 512) { const f32x4 a = ((const GAS f32x4*)F.in[12])[2 * i], b = ((const GAS f32x4*)F.in[12])[2 * i + 1];
        LAS float* p = WEt + (i >> 10) * 8192 + (i & 1023);
        p[0] = a.x; p[1024] = a.y; p[2048] = a.z; p[3072] = a.w; p[4096] = b.x; p[5120] = b.y; p[6144] = b.z; p[7168] = b.w; }
    const int lane = F.lane, w = F.wave;
    bf16* U = (bf16*)(F.ws + WS_U); unsigned* CNT = (unsigned*)(F.ctl + CW_CNT); int* LIST = (int*)(F.ws + WS_LIST); float* WGT = (float*)(F.ws + WS_WGT);
    const float* nw = F.in[9]; const float* bg = F.in[11]; const float* be = F.in[13];
    for (int rb = blockIdx.x; rb < T / 64; rb += F.G) {
        if (F.tid < 32) hist[F.tid] = 0u;
        __syncthreads();
        for (int i = 0; i < 8; ++i) {
            const int rl = w * 8 + i, row = rb * 64 + rl;
            const GAS f32x4* xr = (const GAS f32x4*)(F.out + (size_t)row * D) + lane;
            f32x4 v[4]; float s = 0.f;
#pragma unroll
            for (int j = 0; j < 4; ++j) { v[j] = xr[64 * j]; s += (v[j].x * v[j].x + v[j].y * v[j].y) + (v[j].z * v[j].z + v[j].w * v[j].w); }
            const float rstd = rsqrtf(wave_sum(s) * (1.f / D) + 1e-6f);
            GAS v2u* o8 = (GAS v2u*)(U + (size_t)row * D) + lane;
#pragma unroll
            for (int j = 0; j < 4; ++j) { const f32x4 ww = ((const GAS f32x4*)nw)[lane + 64 * j]; v[j].x *= rstd * ww.x; v[j].y *= rstd * ww.y; v[j].z *= rstd * ww.z; v[j].w *= rstd * ww.w;
                v2u o; o.x = pk2(v[j].x, v[j].y); o.y = pk2(v[j].z, v[j].w); o8[64 * j] = o; }
            float gl[4];
#pragma unroll
            for (int g = 0; g < 4; ++g) { float a = 0.f;
#pragma unroll
                for (int j = 0; j < 4; ++j) { const f32x4 w4 = *(const LAS f32x4*)(WGt + g * 1024 + 4 * (lane + 64 * j)); a += (w4.x * v[j].x + w4.y * v[j].y) + (w4.z * v[j].z + w4.w * v[j].w); }
                gl[g] = wave_sum(a) + bg[g]; }
            int gs = 0; float gm = gl[0];
#pragma unroll
            for (int g = 1; g < 4; ++g) if (gl[g] > gm) { gm = gl[g]; gs = g; }
            const float gw_ = 1.f / (expf(gl[0] - gm) + expf(gl[1] - gm) + expf(gl[2] - gm) + expf(gl[3] - gm));
            gs = __builtin_amdgcn_readfirstlane(gs);
            float el[8];
#pragma unroll
            for (int e = 0; e < 8; ++e) { float a = 0.f;
#pragma unroll
                for (int j = 0; j < 4; ++j) { const f32x4 w4 = *(const LAS f32x4*)(WEt + (gs * 8 + e) * 1024 + 4 * (lane + 64 * j)); a += (w4.x * v[j].x + w4.y * v[j].y) + (w4.z * v[j].z + w4.w * v[j].w); }
                el[e] = wave_sum(a) + be[gs * 8 + e]; }
            int i0 = 0; float v0 = el[0];
#pragma unroll
            for (int e = 1; e < 8; ++e) if (el[e] > v0) { v0 = el[e]; i0 = e; }
            int i1 = -1; float v1 = -3.0e38f;
#pragma unroll
            for (int e = 0; e < 8; ++e) if (e != i0 && el[e] > v1) { v1 = el[e]; i1 = e; }
            const float ee = expf(v1 - v0), w0 = gw_ / (1.f + ee), w1 = gw_ * ee / (1.f + ee);
            if (lane == 0) {
                const unsigned ex0 = (unsigned)(gs * 8 + i0), ex1 = (unsigned)(gs * 8 + i1);
                const unsigned r0 = __hip_atomic_fetch_add(hist + ex0, 1u, __ATOMIC_RELAXED, __HIP_MEMORY_SCOPE_WORKGROUP);
                const unsigned r1 = __hip_atomic_fetch_add(hist + ex1, 1u, __ATOMIC_RELAXED, __HIP_MEMORY_SCOPE_WORKGROUP);
                sel[rl * 2] = ex0 | (r0 << 8); sel[rl * 2 + 1] = ex1 | (r1 << 8);
                WGT[row * 2] = w0; WGT[row * 2 + 1] = w1;
            }
        }
        __syncthreads();
        if (F.tid < 32) { const unsigned hv = hist[F.tid]; base[F.tid] = hv ? atomicAdd(CNT + F.tid, hv) : 0u; }
        __syncthreads();
        if (F.tid < 128) { const unsigned sv = sel[F.tid], e = sv & 255u, rank = sv >> 8;
            LIST[(size_t)e * T + base[e] + rank] = (rb * 64 + (F.tid >> 1)) * 2 + (F.tid & 1); }
    }
}
__device__ __forceinline__ void p6_convert(Frame& F) {
    const int gw = F.vcu * NWAVES + F.wave, NGW = F.G * NWAVES, lane = F.lane;
    __syncthreads();
    LAS float* scr = (LAS float*)(F.lds + RING_OFF + F.wave * 16384);
    bf16* WGU = (bf16*)(F.ws + WS_WGU); bf16* WD = (bf16*)(F.ws + WS_WD);
    for (int it = gw; it < 32 * 768; it += NGW) {
        const int e = it / 768, r = it % 768;
        if (r < 512) { const int gu = r >> 8, q = r & 255, kb = q >> 4, nb = q & 15, n0 = nb * 32;
            transpose_item((gu ? F.in[15] : F.in[14]) + (size_t)e * 1024 * 512, 512, kb * 64, n0, WGU + (size_t)e * 1024 * 1024, 1024, (n0 >> 7) * 256 + gu * 128 + (n0 & 127), scr, lane); }
        else { const int q = r - 512, kb = q >> 5, nb = q & 31;
            transpose_item(F.in[16] + (size_t)e * 512 * 1024, 1024, kb * 64, nb * 32, WD + (size_t)e * 1024 * 512, 512, nb * 32, scr, lane); }
    }
}

__device__ __forceinline__ void p9_final(Frame& F, float* dst) {
    const int gw = F.vcu * NWAVES + F.wave, NGW = F.G * NWAVES, lane = F.lane;
    const bf16* Y = (const bf16*)(F.ws + WS_YBUF); const float* w = F.in[17];
    for (int row = gw; row < T; row += NGW) {
        GAS f32x4* xr = (GAS f32x4*)(F.out + (size_t)row * D) + lane; GAS f32x4* xw = (GAS f32x4*)(dst + (size_t)row * D) + lane;
        const GAS v2u* y0 = (const GAS v2u*)(Y + (size_t)(2 * row) * D) + lane; const GAS v2u* y1 = (const GAS v2u*)(Y + (size_t)(2 * row + 1) * D) + lane;
        f32x4 v[4]; float s = 0.f;
#pragma unroll
        for (int j = 0; j < 4; ++j) { v[j] = xr[64 * j]; const v2u a = y0[64 * j], b = y1[64 * j];
            v[j].x += __uint_as_float(a.x << 16) + __uint_as_float(b.x << 16); v[j].y += __uint_as_float(a.x & 0xffff0000u) + __uint_as_float(b.x & 0xffff0000u);
            v[j].z += __uint_as_float(a.y << 16) + __uint_as_float(b.y << 16); v[j].w += __uint_as_float(a.y & 0xffff0000u) + __uint_as_float(b.y & 0xffff0000u);
            s += (v[j].x * v[j].x + v[j].y * v[j].y) + (v[j].z * v[j].z + v[j].w * v[j].w); }
        const float rstd = rsqrtf(wave_sum(s) * (1.f / D) + 1e-6f);
#pragma unroll
        for (int j = 0; j < 4; ++j) { const f32x4 ww = ((const GAS f32x4*)w)[lane + 64 * j]; xw[64 * j] = (f32x4){v[j].x * rstd * ww.x, v[j].y * rstd * ww.y, v[j].z * rstd * ww.z, v[j].w * rstd * ww.w}; }
    }
}

__device__ __forceinline__ int moe_build_tab(Frame& F) {
    LAS int* tab = (LAS int*)(F.lds + TAB_OFF);
    if (F.tid == 0) { const unsigned* CNT = (const unsigned*)(F.ctl + CW_CNT); int R = 0;
        for (int e = 0; e < 32; ++e) { const int nt = ((int)CNT[e] + 255) >> 8; for (int rt = 0; rt < nt && R < 255; ++rt) tab[R++] = (e << 8) | rt; }
        tab[255] = R; }
    __syncthreads();
    const int NT = tab[255];
    return __builtin_amdgcn_readfirstlane(NT);
}


typedef float f32x2_t __attribute__((ext_vector_type(2))); typedef __bf16 bf16x2_t __attribute__((ext_vector_type(2)));
__device__ __forceinline__ unsigned cvtpk(float lo, float hi) { f32x2_t v = {lo, hi}; bf16x2_t b = __builtin_convertvector(v, bf16x2_t); return __builtin_bit_cast(unsigned, b); }
namespace att {
typedef short s16x4 __attribute__((ext_vector_type(4)));
typedef short v4i16_t __attribute__((ext_vector_type(4)));
constexpr int KOFF = 0, VOFF = 49152, QOFF = 98304;
constexpr float QSCALE = 0.125f * 1.4426950408889634f;
__device__ __forceinline__ int swz_off(int r, int ch) { return r * 128 + ((ch ^ ((r >> 1) & 7)) << 4); }
__device__ __forceinline__ s16x4 vtr(const LAS unsigned char* p) { return __builtin_bit_cast(s16x4, __builtin_amdgcn_ds_read_tr16_b64_v4i16((LAS v4i16_t*)p)); }
__device__ __forceinline__ float blo(unsigned u) { return __uint_as_float(u << 16); }
__device__ __forceinline__ float bhi(unsigned u) { return __uint_as_float(u & 0xffff0000u); }

__device__ __forceinline__ void rope16(v4u& a, v4u& b, const float* rp, float sc) {
    const f32x4 c0 = *(const GAS f32x4*)rp, c1 = *(const GAS f32x4*)(rp + 4), s0 = *(const GAS f32x4*)(rp + 8), s1 = *(const GAS f32x4*)(rp + 12);
    const float cs[8] = {c0.x, c0.y, c0.z, c0.w, c1.x, c1.y, c1.z, c1.w}, sn[8] = {s0.x, s0.y, s0.z, s0.w, s1.x, s1.y, s1.z, s1.w};
    float t1[8], t2[8];
#pragma unroll
    for (int i = 0; i < 4; ++i) { t1[2 * i] = blo(a[i]); t1[2 * i + 1] = bhi(a[i]); t2[2 * i] = blo(b[i]); t2[2 * i + 1] = bhi(b[i]); }
#pragma unroll
    for (int i = 0; i < 4; ++i) {
        a[i] = pk2((t1[2 * i] * cs[2 * i] - t2[2 * i] * sn[2 * i]) * sc, (t1[2 * i + 1] * cs[2 * i + 1] - t2[2 * i + 1] * sn[2 * i + 1]) * sc);
        b[i] = pk2((t2[2 * i] * cs[2 * i] + t1[2 * i] * sn[2 * i]) * sc, (t2[2 * i + 1] * cs[2 * i + 1] + t1[2 * i + 1] * sn[2 * i + 1]) * sc);
    }
}
__device__ __forceinline__ void scale16(v4u& a, v4u& b, float sc) {
#pragma unroll
    for (int i = 0; i < 4; ++i) { a[i] = pk2(blo(a[i]) * sc, bhi(a[i]) * sc); b[i] = pk2(blo(b[i]) * sc, bhi(b[i]) * sc); }
}

__device__ __forceinline__ void attn_unit(Frame& F, int unit) {
    const int p = unit >> 9, b = (unit >> 8) & 1, h = (unit >> 5) & 7, cj = unit & 31;
    const int dl = 2 * p, d = 1 << dl, L = SEQ >> dl, nb = L >> 8;
    const int c = cj / nb, jb = cj - c * nb, i0 = jb * 256;
    const bf16* proj = (const bf16*)(F.ws + WS_PROJ); const float* rope = (const float*)(F.ws + WS_ROPE);
    LAS unsigned char* lds = F.lds;
    const int tid = F.tid, lane = F.lane, w = F.wave;
    {
        v4u ra[8], rb[8]; int pos8[8];
#pragma unroll
        for (int it = 0; it < 8; ++it) {
            const int task = tid + 512 * it;
            const int kind = it < 3 ? 0 : (it < 6 ? 1 : 2);
            const int tl = task - (kind == 0 ? 0 : (kind == 1 ? 1536 : 3072));
            const int r = tl >> 2, g4 = tl & 3;
            const int i = (kind == 2) ? (i0 + r) : (i0 - 64 + r);
            const bool valid = (i >= 0) && (i < L);
            const int pos = i * d + c; pos8[it] = valid ? pos : -1;
            const int col = (kind == 0 ? C_AK : (kind == 1 ? C_AV : C_AQ)) + h * 64 + g4 * 16;
            if (valid) { const GAS v4u* src = (const GAS v4u*)(proj + (size_t)(b * SEQ + pos) * PP + col); ra[it] = src[0]; rb[it] = src[1]; }
            else { ra[it] = (v4u){0u, 0u, 0u, 0u}; rb[it] = (v4u){0u, 0u, 0u, 0u}; }
        }
#pragma unroll
        for (int it = 0; it < 8; ++it) {
            const int task = tid + 512 * it;
            const int kind = it < 3 ? 0 : (it < 6 ? 1 : 2);
            const int tl = task - (kind == 0 ? 0 : (kind == 1 ? 1536 : 3072));
            const int r = tl >> 2, g4 = tl & 3;
            if (kind != 1) {
                if (g4 == 0 && pos8[it] >= 0) rope16(ra[it], rb[it], rope + (size_t)pos8[it] * 16, kind == 2 ? QSCALE : 1.0f);
                else if (kind == 2) scale16(ra[it], rb[it], QSCALE);
            }
            const int base = kind == 0 ? KOFF : (kind == 1 ? VOFF : QOFF);
            *(LAS v4u*)(lds + base + swz_off(r, 2 * g4)) = ra[it];
            *(LAS v4u*)(lds + base + swz_off(r, 2 * g4 + 1)) = rb[it];
        }
    }
    __syncthreads();
    const int fr = lane & 15, g = lane >> 4, q4 = fr >> 2, p4 = fr & 3;
    bf16* opart = (bf16*)(F.ws + WS_PART) + (size_t)p * T * 512;
    float* lse = (float*)(F.ws + WS_PART + (size_t)48 * MiB) + (size_t)p * T * 8;
#pragma unroll
    for (int tt = 0; tt < 2; ++tt) {
        const int ql = 32 * w + 16 * tt + fr;
        bf16x8 qf[2];
#pragma unroll
        for (int s = 0; s < 2; ++s) qf[s] = *(const LAS bf16x8*)(lds + QOFF + swz_off(ql, 4 * s + g));
        f32x4 st[10];
#pragma unroll
        for (int ut = 0; ut < 10; ++ut) {
            st[ut] = (f32x4){0.f, 0.f, 0.f, 0.f};
#pragma unroll
            for (int s = 0; s < 2; ++s) { const bf16x8 kf = *(const LAS bf16x8*)(lds + KOFF + swz_off(32 * w + 16 * ut + fr, 4 * s + g));
                st[ut] = __builtin_amdgcn_mfma_f32_16x16x32_bf16(kf, qf[s], st[ut], 0, 0, 0); }
        }
        float m = -INFINITY;
#pragma unroll
        for (int ut = 0; ut < 10; ++ut)
#pragma unroll
            for (int i = 0; i < 4; ++i) { const int ku = 32 * w + 16 * ut + 4 * g + i, ik = i0 - 64 + ku;
                const bool valid = (ku >= ql) && (ku <= ql + 128) && (ik >= 0) && (ik < L);
                st[ut][i] = valid ? st[ut][i] : -INFINITY; m = fmaxf(m, st[ut][i]); }
        m = fmaxf(m, __shfl_xor(m, 16)); m = fmaxf(m, __shfl_xor(m, 32));
        float l = 0.f;
#pragma unroll
        for (int ut = 0; ut < 10; ++ut)
#pragma unroll
            for (int i = 0; i < 4; ++i) { st[ut][i] = __builtin_amdgcn_exp2f(st[ut][i] - m); l += st[ut][i]; }
        l += __shfl_xor(l, 16); l += __shfl_xor(l, 32);
        f32x4 o[4];
#pragma unroll
        for (int vt = 0; vt < 4; ++vt) o[vt] = (f32x4){0.f, 0.f, 0.f, 0.f};
#pragma unroll
        for (int kp = 0; kp < 5; ++kp) {
            v4u pw; pw.x = cvtpk(st[2 * kp][0], st[2 * kp][1]); pw.y = cvtpk(st[2 * kp][2], st[2 * kp][3]);
            pw.z = cvtpk(st[2 * kp + 1][0], st[2 * kp + 1][1]); pw.w = cvtpk(st[2 * kp + 1][2], st[2 * kp + 1][3]);
            const bf16x8 pf = __builtin_bit_cast(bf16x8, pw);
            const int r0 = 32 * w + 32 * kp + 4 * g + q4, r1 = r0 + 16;
#pragma unroll
            for (int vt = 0; vt < 4; ++vt) {
                const s16x4 a0 = vtr(lds + VOFF + swz_off(r0, 2 * vt + (p4 >> 1)) + 8 * (p4 & 1));
                const s16x4 a1 = vtr(lds + VOFF + swz_off(r1, 2 * vt + (p4 >> 1)) + 8 * (p4 & 1));
                const bf16x8 af = __builtin_shufflevector(a0, a1, 0, 1, 2, 3, 4, 5, 6, 7);
                o[vt] = __builtin_amdgcn_mfma_f32_16x16x32_bf16(af, pf, o[vt], 0, 0, 0);
            }
        }
        const float inv = 1.0f / l;
        const size_t tok = (size_t)b * SEQ + (size_t)(i0 + ql) * d + c;
#pragma unroll
        for (int vt = 0; vt < 4; ++vt) { v2u ov; ov.x = cvtpk(o[vt][0] * inv, o[vt][1] * inv); ov.y = cvtpk(o[vt][2] * inv, o[vt][3] * inv);
            *(GAS v2u*)(opart + tok * 512 + h * 64 + 16 * vt + 4 * g) = ov; }
        if (g == 0) lse[tok * 8 + h] = m + __builtin_amdgcn_logf(l);
    }
    __syncthreads();
}

__device__ __forceinline__ void attn_merge(Frame& F) {
    const bf16* opart = (const bf16*)(F.ws + WS_PART); const float* lse = (const float*)(F.ws + WS_PART + (size_t)48 * MiB);
    bf16* mixed = (bf16*)(F.ws + WS_U);
    for (int task = blockIdx.x * 512 + F.tid; task < T * 64; task += F.G * 512) {
        const int tok = task >> 6, hc = task & 63, h = hc >> 3;
        const float l0 = lse[(size_t)tok * 8 + h], l1 = lse[(size_t)T * 8 + (size_t)tok * 8 + h], l2 = lse[(size_t)2 * T * 8 + (size_t)tok * 8 + h];
        const float mx = fmaxf(l0, fmaxf(l1, l2));
        float w0 = __builtin_amdgcn_exp2f(l0 - mx), w1 = __builtin_amdgcn_exp2f(l1 - mx), w2 = __builtin_amdgcn_exp2f(l2 - mx);
        const float inv = 1.0f / (w0 + w1 + w2); w0 *= inv; w1 *= inv; w2 *= inv;
        const size_t off = (size_t)tok * 512 + hc * 8;
        const v4u a = *(const GAS v4u*)(opart + off), bq = *(const GAS v4u*)(opart + (size_t)T * 512 + off), cq = *(const GAS v4u*)(opart + (size_t)2 * T * 512 + off);
        v4u o;
#pragma unroll
        for (int i = 0; i < 4; ++i) o[i] = pk2(w0 * blo(a[i]) + w1 * blo(bq[i]) + w2 * blo(cq[i]), w0 * bhi(a[i]) + w1 * bhi(bq[i]) + w2 * bhi(cq[i]));
        *(GAS v4u*)(mixed + (size_t)tok * D + 512 + hc * 8) = o;
    }
}
}


namespace gla {
using att::s16x4; using att::vtr; using att::blo; using att::bhi;
constexpr int IMG = 0, VIMG = 32768, LRO = 49152, SEG = 57344, SSQ = 59392;
__device__ __forceinline__ int swz64(int r, int ch) { return r * 128 + ((ch ^ ((r >> 1) & 7)) << 4); }
__device__ __forceinline__ int swzV(int r, int ch) { return r * 256 + ((ch ^ ((r & 7) << 1)) << 4); }
__device__ __forceinline__ float fexp(float x) { return __builtin_amdgcn_exp2f(x * 1.4426950408889634f); }

template <int MODE>
__device__ __forceinline__ void gla_prep(Frame& F, int b, int n, int h) {
    const bf16* proj = (const bf16*)(F.ws + WS_PROJ);
    LAS unsigned char* lds = F.lds; const int tid = F.tid;
    const int dir = tid >> 8, seg = (tid >> 6) & 3, d = tid & 63;
    const size_t tok0 = (size_t)b * SEQ + (size_t)n * 64;
    { const int t = tid >> 3, c4 = (tid & 7) * 4;
      const v2u raw = *(const GAS v2u*)(proj + (tok0 + t) * PP + C_LF + c4);
      *(LAS f32x4*)(lds + LRO + (t * 32 + c4) * 4) = (f32x4){blo(raw.x), bhi(raw.x), blo(raw.y), bhi(raw.y)}; }
#pragma unroll
    for (int it = 0; it < 2; ++it) { const int task = tid + 512 * it, t = task >> 4, ch = task & 15;
      *(LAS v4u*)(lds + VIMG + swzV(t, ch)) = *(const GAS v4u*)(proj + (tok0 + t) * PP + C_GV + h * 128 + ch * 8); }
    const float* W = dir ? F.in[5] : F.in[3]; const float* Bv = dir ? F.in[6] : F.in[4];
    float wr[16];
#pragma unroll
    for (int r = 0; r < 16; ++r) wr[r] = W[r * 256 + h * 64 + d];
    const float bias = Bv[h * 64 + d];
    float kv_[16], qv_[16];
#pragma unroll
    for (int i = 0; i < 16; ++i) { const size_t row = (tok0 + seg * 16 + i) * PP; kv_[i] = bf2f(proj[row + C_GK + h * 64 + d]); if (MODE == 1) qv_[i] = bf2f(proj[row + C_GQ + h * 64 + d]) * 0.125f; }
    __syncthreads();
    float c[16];
#pragma unroll
    for (int i = 0; i < 16; ++i) { const LAS f32x4* lp = (const LAS f32x4*)(lds + LRO + ((seg * 16 + i) * 32 + dir * 16) * 4);
        float z = bias;
#pragma unroll
        for (int r4 = 0; r4 < 4; ++r4) { const f32x4 lv = lp[r4]; z += lv.x * wr[4 * r4] + lv.y * wr[4 * r4 + 1] + lv.z * wr[4 * r4 + 2] + lv.w * wr[4 * r4 + 3]; }
        c[i] = (fminf(z, 0.f) - __builtin_amdgcn_logf(1.0f + fexp(-fabsf(z))) * 0.6931471805599453f) * 0.0625f; }
    if (dir == 0) {
#pragma unroll
        for (int i = 1; i < 16; ++i) c[i] += c[i - 1]; }
    else {
#pragma unroll
        for (int i = 14; i >= 0; --i) c[i] += c[i + 1]; }
    LAS float* segp = (LAS float*)(lds + SEG);
    segp[(dir * 4 + seg) * 64 + d] = dir == 0 ? c[15] : c[0];
    __syncthreads();
    float offs = 0.f, tot = 0.f;
#pragma unroll
    for (int s = 0; s < 4; ++s) { const float sv = segp[(dir * 4 + s) * 64 + d]; tot += sv; if (dir == 0 ? (s < seg) : (s > seg)) offs += sv; }
#pragma unroll
    for (int i = 0; i < 16; ++i) { const int t = seg * 16 + i; const float bb = c[i] + offs;
        const int eo = swz64(t, d >> 3) + (d & 7) * 2;
        if (MODE == 0) { *(LAS bf16*)(lds + IMG + dir * 8192 + eo) = f2bf(kv_[i] * fexp(tot - bb)); }
        else { *(LAS bf16*)(lds + IMG + (2 * dir) * 8192 + eo) = f2bf(qv_[i] * fexp(bb)); *(LAS bf16*)(lds + IMG + (2 * dir + 1) * 8192 + eo) = f2bf(kv_[i] * fexp(-bb)); } }
    if (MODE == 0 && seg == 0) { float* dec = (float*)(F.ws + WS_DEC); dec[((size_t)((b * 4 + h) * 2 + dir) * 128 + n) * 64 + d] = fexp(tot); }
    __syncthreads();
}

__device__ __forceinline__ void gla_unit_a(Frame& F, int unit) {
    const int b = unit >> 9, n = (unit >> 2) & 127, h = unit & 3;
    gla_prep<0>(F, b, n, h);
    LAS unsigned char* lds = F.lds; const int lane = F.lane, w = F.wave;
    const int fr = lane & 15, g = lane >> 4, q4 = fr >> 2, p4 = fr & 3;
    const int dir = w >> 2, vcp = w & 3;
    f32x4 acc[4][2];
#pragma unroll
    for (int dt = 0; dt < 4; ++dt)
#pragma unroll
        for (int v = 0; v < 2; ++v) acc[dt][v] = (f32x4){0.f, 0.f, 0.f, 0.f};
#pragma unroll
    for (int s = 0; s < 2; ++s) {
        const int r0 = 32 * s + 8 * g + q4, r1 = r0 + 4;
        bf16x8 vf[2];
#pragma unroll
        for (int v = 0; v < 2; ++v) { const int ch = 2 * (2 * vcp + v) + (p4 >> 1);
            const s16x4 a0 = vtr(lds + VIMG + swzV(r0, ch) + 8 * (p4 & 1)), a1 = vtr(lds + VIMG + swzV(r1, ch) + 8 * (p4 & 1));
            vf[v] = __builtin_shufflevector(a0, a1, 0, 1, 2, 3, 4, 5, 6, 7); }
#pragma unroll
        for (int dt = 0; dt < 4; ++dt) { const int ch = 2 * dt + (p4 >> 1);
            const s16x4 a0 = vtr(lds + IMG + dir * 8192 + swz64(r0, ch) + 8 * (p4 & 1)), a1 = vtr(lds + IMG + dir * 8192 + swz64(r1, ch) + 8 * (p4 & 1));
            const bf16x8 kf = __builtin_shufflevector(a0, a1, 0, 1, 2, 3, 4, 5, 6, 7);
#pragma unroll
            for (int v = 0; v < 2; ++v) acc[dt][v] = __builtin_amdgcn_mfma_f32_16x16x32_bf16(kf, vf[v], acc[dt][v], 0, 0, 0); }
    }
    bf16* kvb = (bf16*)(F.ws + WS_KV) + ((size_t)((b * 4 + h) * 2 + dir) * 128 + n) * 8192;
#pragma unroll
    for (int dt = 0; dt < 4; ++dt)
#pragma unroll
        for (int v = 0; v < 2; ++v) { const int vc = 16 * (2 * vcp + v) + fr; v2u o; o.x = cvtpk(acc[dt][v][0], acc[dt][v][1]); o.y = cvtpk(acc[dt][v][2], acc[dt][v][3]);
            *(GAS v2u*)(kvb + vc * 64 + 16 * dt + 4 * g) = o; }
    __syncthreads();
}

__device__ __forceinline__ void gla_scan(Frame& F) {
    if (F.tid >= 256) return;
    for (int e2 = blockIdx.x * 256 + F.tid; e2 < 65536; e2 += F.G * 256) {
    const int combo = e2 >> 12, rem = e2 & 4095, d2 = rem & 31, dir = combo & 1;
    unsigned* kvw = (unsigned*)(F.ws + WS_KV) + (size_t)combo * 128 * 4096 + rem;
    const float* dec = (const float*)(F.ws + WS_DEC) + (size_t)combo * 128 * 64 + 2 * d2;
    float s0 = 0.f, s1 = 0.f;
    for (int nb = 0; nb < 128; nb += 8) {
        unsigned kvr[8]; float2 dc[8];
#pragma unroll
        for (int j = 0; j < 8; ++j) { const int n = dir ? (127 - nb - j) : (nb + j); kvr[j] = kvw[(size_t)n * 4096]; dc[j] = *(const float2*)(dec + n * 64); }
#pragma unroll
        for (int j = 0; j < 8; ++j) { const int n = dir ? (127 - nb - j) : (nb + j);
            kvw[(size_t)n * 4096] = pk2(s0, s1);
            s0 = s0 * dc[j].x + blo(kvr[j]); s1 = s1 * dc[j].y + bhi(kvr[j]); }
    }
    }
}

__device__ __forceinline__ void gla_unit_c(Frame& F, int unit) {
    const int b = unit >> 9, n = (unit >> 2) & 127, h = unit & 3;
    gla_prep<1>(F, b, n, h);
    const bf16* proj = (const bf16*)(F.ws + WS_PROJ);
    LAS unsigned char* lds = F.lds; const int lane = F.lane, w = F.wave;
    const int fr = lane & 15, g = lane >> 4, q4 = fr >> 2, p4 = fr & 3;
    const int tt = w & 3, vh = w >> 2;
    f32x4 o[4];
#pragma unroll
    for (int vt = 0; vt < 4; ++vt) o[vt] = (f32x4){0.f, 0.f, 0.f, 0.f};
    const int tq = 16 * tt + fr;
#pragma unroll
    for (int dir = 0; dir < 2; ++dir) {
        bf16x8 qf[2];
#pragma unroll
        for (int s = 0; s < 2; ++s) qf[s] = *(const LAS bf16x8*)(lds + IMG + (2 * dir) * 8192 + swz64(tq, 4 * s + g));
        f32x4 st[4];
#pragma unroll
        for (int ut = 0; ut < 4; ++ut) { st[ut] = (f32x4){0.f, 0.f, 0.f, 0.f};
#pragma unroll
            for (int s = 0; s < 2; ++s) { const bf16x8 kf = *(const LAS bf16x8*)(lds + IMG + (2 * dir + 1) * 8192 + swz64(16 * ut + fr, 4 * s + g));
                st[ut] = __builtin_amdgcn_mfma_f32_16x16x32_bf16(kf, qf[s], st[ut], 0, 0, 0); }
#pragma unroll
            for (int i = 0; i < 4; ++i) { const int u = 16 * ut + 4 * g + i; const bool keep = dir == 0 ? (u <= tq) : (u >= tq); st[ut][i] = keep ? st[ut][i] : 0.f; } }
        const bf16* stb = (const bf16*)(F.ws + WS_KV) + ((size_t)((b * 4 + h) * 2 + dir) * 128 + n) * 8192;
#pragma unroll
        for (int kp = 0; kp < 2; ++kp) {
            v4u pw; pw.x = cvtpk(st[2 * kp][0], st[2 * kp][1]); pw.y = cvtpk(st[2 * kp][2], st[2 * kp][3]);
            pw.z = cvtpk(st[2 * kp + 1][0], st[2 * kp + 1][1]); pw.w = cvtpk(st[2 * kp + 1][2], st[2 * kp + 1][3]);
            const bf16x8 pf = __builtin_bit_cast(bf16x8, pw);
            const int r0 = 32 * kp + 4 * g + q4, r1 = r0 + 16;
#pragma unroll
            for (int vt = 0; vt < 4; ++vt) { const int ch = 8 * vh + 2 * vt + (p4 >> 1);
                const s16x4 a0 = vtr(lds + VIMG + swzV(r0, ch) + 8 * (p4 & 1)), a1 = vtr(lds + VIMG + swzV(r1, ch) + 8 * (p4 & 1));
                const bf16x8 af = __builtin_shufflevector(a0, a1, 0, 1, 2, 3, 4, 5, 6, 7);
                o[vt] = __builtin_amdgcn_mfma_f32_16x16x32_bf16(af, pf, o[vt], 0, 0, 0); }
        }
#pragma unroll
        for (int s = 0; s < 2; ++s)
#pragma unroll
            for (int vt = 0; vt < 4; ++vt) { const bf16x8 sf = *(const GAS bf16x8*)(stb + (size_t)(64 * vh + 16 * vt + fr) * 64 + 32 * s + 8 * g);
                o[vt] = __builtin_amdgcn_mfma_f32_16x16x32_bf16(sf, qf[s], o[vt], 0, 0, 0); }
    }
    float ss = 0.f;
#pragma unroll
    for (int vt = 0; vt < 4; ++vt) ss += (o[vt][0] * o[vt][0] + o[vt][1] * o[vt][1]) + (o[vt][2] * o[vt][2] + o[vt][3] * o[vt][3]);
    ss += __shfl_xor(ss, 16); ss += __shfl_xor(ss, 32);
    LAS float* ssq = (LAS float*)(lds + SSQ);
    if (g == 0) ssq[vh * 64 + tq] = ss;
    __syncthreads();
    const float rstd = rsqrtf((ssq[tq] + ssq[64 + tq]) * (1.0f / 128.0f) + 1e-6f);
    const size_t tok = (size_t)b * SEQ + (size_t)n * 64 + tq;
    bf16* mixed = (bf16*)(F.ws + WS_U);
#pragma unroll
    for (int vt = 0; vt < 4; ++vt) { const int vc = 64 * vh + 16 * vt + 4 * g;
        const v2u gr = *(const GAS v2u*)(proj + tok * PP + C_GG + h * 128 + vc); const f32x4 nw = *(const GAS f32x4*)(F.in[7] + vc);
        const float g0 = blo(gr.x), g1 = bhi(gr.x), g2 = blo(gr.y), g3 = bhi(gr.y);
        v2u ov; ov.x = cvtpk(pg8::silu_mul(g0, o[vt][0] * rstd * nw.x), pg8::silu_mul(g1, o[vt][1] * rstd * nw.y));
        ov.y = cvtpk(pg8::silu_mul(g2, o[vt][2] * rstd * nw.z), pg8::silu_mul(g3, o[vt][3] * rstd * nw.w));
        *(GAS v2u*)(mixed + tok * D + h * 128 + vc) = ov; }
    __syncthreads();
}
}

struct Args { const float* in[18]; float* out; unsigned char* ws; int ph_lo, ph_hi, li, pad; };
__global__ void __launch_bounds__(NWAVES * 64, 2) mk_fwd(Args args) {
    extern __shared__ __attribute__((aligned(16))) unsigned char lds[];
    Frame F;
    F.lds = (LAS unsigned char*)lds;
    F.MISC = (volatile LAS unsigned*)(F.lds + MISC_OFF);
    F.tid = threadIdx.x; F.lane = F.tid & 63; F.wave = __builtin_amdgcn_readfirstlane(F.tid >> 6);
    F.G = gridDim.x; { const int bx = blockIdx.x; F.vcu = (F.G % 8 == 0) ? (bx % 8) * (F.G / 8) + bx / 8 : bx; }
    F.ws = args.ws; F.out = args.out; F.ctl = (gu32*)(args.ws + WS_CTL);
#pragma unroll
    for (int i = 0; i < 18; ++i) F.in[i] = args.in[i];
    for (int u = F.tid; u < (LDS_BYTES - TAB_OFF) / 4; u += NWAVES * 64) ((LAS unsigned*)(F.lds + TAB_OFF))[u] = 0u;
    __syncthreads();
    XcdBarrier bar = xcd_barrier_post((unsigned*)(F.ctl + CW_BAR) + args.li * XCD_BAR_WORDS, F.MISC + 8);
    const int lo = args.ph_lo, hi = args.ph_hi;
#define IN(k) (lo <= (k) && (k) < hi)
#define BOTH(k) (IN(k) && IN((k) + 1))
#define GRID_BAR() xcd_barrier(bar)

#ifndef REP0
#define REP0 1
#define REP1 1
#define REP2 1
#define REP4 1
#define REP5 1
#define REP7 1
#define REP8 1
#define REP2G 1
#define REP2A 1
#define REP3 1
#define REP6C 1
#define REP9 1
#define REP4G 1
#define REP4M 1
#endif
    if (IN(0)) { _Pragma("unroll") for (int rep = 0; rep < REP0; ++rep) p0_prologue(F); if (BOTH(0)) GRID_BAR(); }

    if (IN(1)) _Pragma("unroll") for (int rep = 0; rep < REP1; ++rep) {
        pg8::StaticOrder S; S.init(F.ws + WS_U, F.ws + WS_WIN, T, PP, D, F.G, (int)blockIdx.x);
        pg8::EpiBf16 E{(bf16*)(F.ws + WS_PROJ), PP};
        pg8::gemm_phase<pg8::EpiBf16, pg8::StaticOrder, false, true>(F.lds + RING_OFF, D, S, E);
    }
    if (BOTH(1)) GRID_BAR();

    if (IN(2)) { _Pragma("unroll") for (int rep = 0; rep < REP2; ++rep) {
        _Pragma("unroll") for (int r2 = 0; r2 < REP2G; ++r2) for (int u = blockIdx.x; u < 1024; u += F.G) gla::gla_unit_a(F, u);
        _Pragma("unroll") for (int r2 = 0; r2 < REP2A; ++r2) for (int u = blockIdx.x; u < 1536; u += F.G) att::attn_unit(F, u); }
        if (BOTH(2)) GRID_BAR(); }

    if (IN(3)) { gla::gla_scan(F);
        _Pragma("unroll") for (int r3 = 1; r3 < REP3; ++r3) { GRID_BAR(); for (int u = blockIdx.x; u < 1024; u += F.G) gla::gla_unit_a(F, u); GRID_BAR(); gla::gla_scan(F); }
        if (BOTH(3)) GRID_BAR(); }

    if (IN(4)) { _Pragma("unroll") for (int rep = 0; rep < REP4; ++rep) {
        _Pragma("unroll") for (int r2 = 0; r2 < REP4G; ++r2) for (int u = blockIdx.x; u < 1024; u += F.G) gla::gla_unit_c(F, u);
        _Pragma("unroll") for (int r2 = 0; r2 < REP4M; ++r2) att::attn_merge(F); }
        if (BOTH(4)) GRID_BAR(); }

    if (IN(5)) _Pragma("unroll") for (int rep = 0; rep < REP5; ++rep) {
        pg8::StaticOrder S; S.init(F.ws + WS_U, F.ws + WS_WOUT, T, D, D, F.G, (int)blockIdx.x);
        pg8::EpiF32Res E{F.out, F.in[0], D};
        pg8::gemm_phase<pg8::EpiF32Res, pg8::StaticOrder, false, false>(F.lds + RING_OFF, D, S, E);
    }
    if (BOTH(5)) GRID_BAR();

    if (IN(6)) { p6_router(F); _Pragma("unroll") for (int r6 = 0; r6 < REP6C; ++r6) p6_convert(F); if (BOTH(6)) GRID_BAR(); }

    if (IN(7)) _Pragma("unroll") for (int rep = 0; rep < REP7; ++rep) {
        const int NT = moe_build_tab(F);
        pg8::MoeOrder<true> S{(const char*)(F.ws + WS_U), (const char*)(F.ws + WS_WGU), (size_t)1024 * 1024 * 2, D, NT * 4, F.G, (int)blockIdx.x,
                              (const LAS int*)(F.lds + TAB_OFF), (const unsigned*)(F.ctl + CW_CNT), (const int*)(F.ws + WS_LIST)};
        pg8::EpiGateUp E{(bf16*)(F.ws + WS_ACT)};
        pg8::gemm_phase<pg8::EpiGateUp, pg8::MoeOrder<true>, true, true>(F.lds + RING_OFF, D, S, E);
    }
    if (BOTH(7)) GRID_BAR();

    if (IN(8)) _Pragma("unroll") for (int rep = 0; rep < REP8; ++rep) {
        const int NT = moe_build_tab(F);
        pg8::MoeOrder<false> S{(const char*)(F.ws + WS_ACT), (const char*)(F.ws + WS_WD), (size_t)1024 * 512 * 2, 512, NT * 4, F.G, (int)blockIdx.x,
                               (const LAS int*)(F.lds + TAB_OFF), (const unsigned*)(F.ctl + CW_CNT), (const int*)(F.ws + WS_LIST)};
        pg8::EpiDown E{(bf16*)(F.ws + WS_YBUF), (const int*)(F.ws + WS_LIST), (const unsigned*)(F.ctl + CW_CNT), (const float*)(F.ws + WS_WGT)};
        pg8::gemm_phase<pg8::EpiDown, pg8::MoeOrder<false>, false, true>(F.lds + RING_OFF, 512, S, E);
    }
    if (BOTH(8)) GRID_BAR();

    if (IN(9)) { _Pragma("unroll") for (int r9 = 1; r9 < REP9; ++r9) p9_final(F, (float*)(F.ws + WS_PROJ)); p9_final(F, F.out); }
#undef IN
#undef BOTH
#undef GRID_BAR
}

#ifndef OPT_MOE
#define OPT_MOE 1
#endif
static void launch_mk(const Args& base, int lo, int hi, int li, int grid, hipStream_t stream, int sub = 3) {
    Args a = base; a.ph_lo = lo; a.ph_hi = hi; a.li = li; a.pad = sub;
    hipLaunchKernelGGL(mk_fwd, dim3(grid), dim3(NWAVES * 64), LDS_BYTES, stream, a);
}
extern "C" void kernel_launch(void* const* d_in, const int* in_sizes, int n_in, void* d_out, int out_size, void* d_ws, size_t ws_size, hipStream_t stream) {
    static int grid = 0;
    if (grid == 0) {
        int dev = 0, cus = 0;
        if (hipGetDevice(&dev) != hipSuccess || hipDeviceGetAttribute(&cus, hipDeviceAttributeMultiprocessorCount, dev) != hipSuccess) { grid = -1; return; }
        if (hipFuncSetAttribute((const void*)mk_fwd, hipFuncAttributeMaxDynamicSharedMemorySize, LDS_BYTES) != hipSuccess) { fprintf(stderr, "kernel_launch: hipFuncSetAttribute failed\n"); grid = -1; return; }
        (void)hipGetLastError();
        grid = cus;
    }
    if (grid < 0) return;
    const float* x = (const float*)d_in[0];
    const float* wf = (const float*)d_in[3]; const float* bfv = (const float*)d_in[4]; const float* wb = (const float*)d_in[5]; const float* bb = (const float*)d_in[6];
    const float* gnw = (const float*)d_in[7]; const float* norm2_w = (const float*)d_in[9];
    const float* rgw = (const float*)d_in[10]; const float* rgb = (const float*)d_in[11]; const float* rew = (const float*)d_in[12]; const float* reb = (const float*)d_in[13];
    const float* ewg = (const float*)d_in[14]; const float* ewu = (const float*)d_in[15]; const float* ewd = (const float*)d_in[16]; const float* fnw = (const float*)d_in[17];
    unsigned char* ws = (unsigned char*)d_ws; float* out = (float*)d_out;
    bf16* U = (bf16*)(ws + WS_U); bf16* PROJ = (bf16*)(ws + WS_PROJ); float* ODIR = (float*)(ws + WS_PART); bf16* YBUF = (bf16*)(ws + WS_YBUF);
    unsigned* CNT = (unsigned*)(ws + WS_CTL) + CW_CNT; int* LIST = (int*)(ws + WS_LIST); float* WGT = (float*)(ws + WS_WGT);
    (void)hipMemsetAsync(ws + WS_CTL, 0, 1 * MiB, stream);
    Args a{};
    for (int i = 0; i < 18; ++i) a.in[i] = (const float*)d_in[i];
    a.out = out; a.ws = ws;
    launch_mk(a, 0, 10, 0, grid, stream, 3);
}
```

```cpp
#include <hip/hip_runtime.h>
#include <cstdio>
#include <cstdint>

typedef unsigned short bf16;
constexpr int T = 16384, SEQ = 8192, D = 1024;
constexpr int PP = 3328;
constexpr int C_GQ = 0, C_GK = 256, C_GV = 512, C_GG = 1024, C_AQ = 1536, C_AK = 2048, C_AV = 2560, C_LF = 3072, C_LB = 3088;
constexpr int INW = 3104;
constexpr size_t MiB = 1u << 20;
constexpr size_t WS_CTL = 0, WS_U = 10 * MiB, WS_PROJ = 42 * MiB, WS_KV = 146 * MiB, WS_PART = 178 * MiB, WS_YBUF = 42 * MiB  , WS_H1 = 186 * MiB  ,
                 WS_LIST = 250 * MiB, WS_WGT = 252 * MiB;
constexpr int CW_CNT = 1024;

__device__ __forceinline__ float bf2f(bf16 b) { return __uint_as_float(((unsigned)b) << 16); }
__device__ __forceinline__ bf16 f2bf(float f) { unsigned u = __float_as_uint(f); return (bf16)((u + 0x7fffu + ((u >> 16) & 1u)) >> 16); }
__device__ __forceinline__ float wave_sum(float v) {
#pragma unroll
    for (int o = 1; o < 64; o <<= 1) v += __shfl_xor(v, o);
    return v;
}

namespace pg8 {
#define PG8_LAS __attribute__((address_space(3)))
typedef unsigned short bf16_t;
typedef short bf16x8 __attribute__((ext_vector_type(8)));
typedef float f32x4 __attribute__((ext_vector_type(4)));
typedef unsigned u32x4 __attribute__((ext_vector_type(4)));
constexpr int BM = 256, BK = 64, HALF = 128, HTB = HALF * BK * 2  , STAGE_BYTES = 8 * HTB, NXCD = 8, WGM = 8;

__host__ __device__ __forceinline__ int lds_byte(int r, int c) { const int st = (r >> 4) * 2 + (c >> 5), rr = r & 15, cc = c & 31, ob = rr * 64 + cc * 2; return st * 1024 + (ob ^ (((ob >> 9) & 1) << 5)); }
__host__ __device__ __forceinline__ void stage_rc(int b, int& R, int& C) { const int st = b / 1024, sb = b % 1024, swz = sb ^ (((sb >> 9) & 1) << 5); R = (st >> 1) * 16 + swz / 64; C = (st & 1) * 32 + (swz % 64) / 2; }
__host__ __device__ __forceinline__ int perm32(int rho) { const int n = rho >> 4, i = rho & 15; return 8 * (i >> 2) + 4 * n + (i & 3); }

struct Unit { int pm, pn, aux; };

struct StaticOrder {
    const char* A; const char* Bt; int K, nM, nN, nwg, G, c;
    __device__ void init(const void* A_, const void* Bt_, int M, int N, int K_, int G_, int c_) { A = (const char*)A_; Bt = (const char*)Bt_; K = K_; nM = M / BM; nN = N / BM; nwg = nM * nN; G = G_; c = c_; }
    __device__ bool next(int i, Unit& u) const {
        const long L = (long)i * G + c; if (L >= nwg) return false;
        int wgid = (int)L; { const int q = nwg / NXCD, r = nwg % NXCD, xcd = wgid % NXCD, off = wgid / NXCD; wgid = (xcd < r ? xcd * (q + 1) : r * (q + 1) + (xcd - r) * q) + off; }
        const int nig = WGM * nN, gid = wgid / nig, fm = gid * WGM, gsz = (nM - fm) < WGM ? (nM - fm) : WGM;
        u.pm = fm + ((wgid % nig) % gsz); u.pn = (wgid % nig) / gsz; u.aux = 0; return true;
    }
    __device__ __forceinline__ const char* a_base(const Unit& u) const { return A + (size_t)u.pm * BM * K * 2; }
    __device__ __forceinline__ const char* b_base(const Unit& u) const { return Bt + (size_t)u.pn * BM * K * 2; }
    __device__ __forceinline__ unsigned a_off(const Unit&, int r) const { return (unsigned)(r * K * 2); }
};
template <bool GATHER> struct MoeOrder {
    const char* A; const char* Bt; size_t estride; int K, total, G, c; const PG8_LAS int* tab; const unsigned* cnt; const int* list;
    __device__ bool next(int i, Unit& u) const {
        const long L = (long)i * G + c; if (L >= total) return false;
        int id = (int)L; { const int q = total / NXCD, r = total % NXCD, xcd = id % NXCD, off = id / NXCD; id = (xcd < r ? xcd * (q + 1) : r * (q + 1) + (xcd - r) * q) + off; }
        u.pm = id >> 2; u.pn = id & 3; u.aux = tab[u.pm]; return true;
    }
    __device__ __forceinline__ const char* a_base(const Unit& u) const { return GATHER ? A : A + (size_t)u.pm * BM * K * 2; }
    __device__ __forceinline__ const char* b_base(const Unit& u) const { return Bt + (size_t)(u.aux >> 8) * estride + (size_t)u.pn * BM * K * 2; }
    __device__ __forceinline__ unsigned a_off(const Unit& u, int r) const {
        if (!GATHER) return (unsigned)(r * K * 2);
        const int e = u.aux >> 8, idx = (u.aux & 255) * 256 + r; const int n = (int)cnt[e];
        const int tok = idx < n ? (list[(size_t)e * 16384 + idx] >> 1) : 0;
        return (unsigned)tok * (unsigned)(K * 2);
    }
};

__device__ __forceinline__ unsigned cvt_pk_bf16(float lo, float hi) { unsigned r; asm volatile("v_cvt_pk_bf16_f32 %0, %1, %2" : "=v"(r) : "v"(lo), "v"(hi)); return r; }

struct EpiBf16 {
    static constexpr bool PERM = true, AFTER_DRAIN = false;
    bf16_t* O; int ldc;
    __device__ __forceinline__ void operator()(const f32x4 (&acc)[2][2][4][2], const Unit& u, int wr, int wc, int fr, int fq) const {
        const int row0 = u.pm * BM + wr * 64 + fr, col0 = u.pn * BM + wc * 32 + 8 * fq;
#pragma unroll
        for (int ai = 0; ai < 2; ++ai)
#pragma unroll
            for (int m = 0; m < 4; ++m) { bf16_t* rowp = O + (size_t)(row0 + ai * HALF + m * 16) * ldc + col0;
#pragma unroll
                for (int bj = 0; bj < 2; ++bj) { const f32x4 v0 = acc[ai][bj][m][0], v1 = acc[ai][bj][m][1];
                    u32x4 w; w.x = cvt_pk_bf16(v0[0], v0[1]); w.y = cvt_pk_bf16(v0[2], v0[3]); w.z = cvt_pk_bf16(v1[0], v1[1]); w.w = cvt_pk_bf16(v1[2], v1[3]);
                    *(u32x4*)(rowp + bj * HALF) = w; } }
    }
};
struct EpiProj {
    static constexpr bool PERM = true, AFTER_DRAIN = false;
    bf16_t* O; int ldc; const float* rope;
    __device__ __forceinline__ void operator()(const f32x4 (&acc)[2][2][4][2], const Unit& u, int wr, int wc, int fr, int fq) const {
        const int row0 = u.pm * BM + wr * 64 + fr, col0 = u.pn * BM + wc * 32 + 8 * fq;
        const bool isq = (u.pn == 6) || (u.pn == 7), isk = (u.pn == 8) || (u.pn == 9);
        const bool dorope = (isq || isk) && ((wc & 1) == 0);
        const float qs = isq ? (0.125f * 1.4426950408889634f) : 1.0f;
#pragma unroll
        for (int ai = 0; ai < 2; ++ai)
#pragma unroll
            for (int m = 0; m < 4; ++m) { const int row = row0 + ai * HALF + m * 16; bf16_t* rowp = O + (size_t)row * ldc + col0;
                f32x4 c0, c1, s0, s1;
                if (dorope) { const float* rp = rope + (size_t)(row & 8191) * 16; c0 = *(const f32x4*)rp; c1 = *(const f32x4*)(rp + 4); s0 = *(const f32x4*)(rp + 8); s1 = *(const f32x4*)(rp + 12); }
#pragma unroll
                for (int bj = 0; bj < 2; ++bj) { f32x4 v0 = acc[ai][bj][m][0], v1 = acc[ai][bj][m][1];
                    if (dorope) { f32x4 p0, p1;
#pragma unroll
                        for (int j = 0; j < 4; ++j) { p0[j] = __shfl_xor(v0[j], 16); p1[j] = __shfl_xor(v1[j], 16); }
                        if (fq == 0) { v0 = v0 * c0 - p0 * s0; v1 = v1 * c1 - p1 * s1; }
                        else if (fq == 1) { v0 = v0 * c0 + p0 * s0; v1 = v1 * c1 + p1 * s1; } }
                    v0 = v0 * qs; v1 = v1 * qs;
                    u32x4 w; w.x = cvt_pk_bf16(v0[0], v0[1]); w.y = cvt_pk_bf16(v0[2], v0[3]); w.z = cvt_pk_bf16(v1[0], v1[1]); w.w = cvt_pk_bf16(v1[2], v1[3]);
                    *(u32x4*)(rowp + bj * HALF) = w; } }
    }
};
struct EpiF32Res {
    static constexpr bool PERM = false, AFTER_DRAIN = false;
    float* C; const float* res; int ldc;
    __device__ __forceinline__ void operator()(const f32x4 (&acc)[2][2][4][2], const Unit& u, int wr, int wc, int fr, int fq) const {
        const int row0 = u.pm * BM + wr * 64 + fr, col0 = u.pn * BM + wc * 32 + 4 * fq;
#pragma unroll
        for (int ai = 0; ai < 2; ++ai) { f32x4 rv[4][2][2];
#pragma unroll
            for (int m = 0; m < 4; ++m) { const size_t off = (size_t)(row0 + ai * HALF + m * 16) * ldc + col0;
#pragma unroll
                for (int bj = 0; bj < 2; ++bj)
#pragma unroll
                    for (int n = 0; n < 2; ++n) rv[m][bj][n] = __builtin_nontemporal_load((const f32x4*)(res + off + bj * HALF + n * 16)); }
#pragma unroll
            for (int m = 0; m < 4; ++m) { const size_t off = (size_t)(row0 + ai * HALF + m * 16) * ldc + col0;
#pragma unroll
                for (int bj = 0; bj < 2; ++bj)
#pragma unroll
                    for (int n = 0; n < 2; ++n) *(f32x4*)(C + off + bj * HALF + n * 16) = rv[m][bj][n] + acc[ai][bj][m][n]; }
            asm volatile("" ::: "memory"); }
    }
};
struct EpiBf16Res {
    static constexpr bool PERM = true, AFTER_DRAIN = false;
    bf16_t* H; const float* res; int ldc;
    __device__ __forceinline__ void operator()(const f32x4 (&acc)[2][2][4][2], const Unit& u, int wr, int wc, int fr, int fq) const {
        const int row0 = u.pm * BM + wr * 64 + fr, col0 = u.pn * BM + wc * 32 + 8 * fq;
#pragma unroll
        for (int ai = 0; ai < 2; ++ai) { f32x4 rv[4][2][2];
#pragma unroll
            for (int m = 0; m < 4; ++m) { const size_t off = (size_t)(row0 + ai * HALF + m * 16) * ldc + col0;
#pragma unroll
                for (int bj = 0; bj < 2; ++bj)
#pragma unroll
                    for (int n = 0; n < 2; ++n) rv[m][bj][n] = __builtin_nontemporal_load((const f32x4*)(res + off + bj * HALF + n * 4)); }
#pragma unroll
            for (int m = 0; m < 4; ++m) { const size_t off = (size_t)(row0 + ai * HALF + m * 16) * ldc + col0;
#pragma unroll
                for (int bj = 0; bj < 2; ++bj) { const f32x4 v0 = rv[m][bj][0] + acc[ai][bj][m][0], v1 = rv[m][bj][1] + acc[ai][bj][m][1];
                    u32x4 w; w.x = cvt_pk_bf16(v0[0], v0[1]); w.y = cvt_pk_bf16(v0[2], v0[3]); w.z = cvt_pk_bf16(v1[0], v1[1]); w.w = cvt_pk_bf16(v1[2], v1[3]);
                    *(u32x4*)(H + off + bj * HALF) = w; } }
            asm volatile("" ::: "memory"); }
    }
};
__device__ __forceinline__ float silu_mul(float g, float u) { return g * u * __builtin_amdgcn_rcpf(1.0f + __builtin_amdgcn_exp2f(-1.4426950408889634f * g)); }
struct EpiGateUp {
    static constexpr bool PERM = true, AFTER_DRAIN = false;
    bf16_t* ACT;
    __device__ __forceinline__ void operator()(const f32x4 (&acc)[2][2][4][2], const Unit& u, int wr, int wc, int fr, int fq) const {
        const int row0 = u.pm * BM + wr * 64 + fr, col0 = u.pn * HALF + wc * 32 + 8 * fq;
#pragma unroll
        for (int ai = 0; ai < 2; ++ai)
#pragma unroll
            for (int m = 0; m < 4; ++m) { bf16_t* rowp = ACT + (size_t)(row0 + ai * HALF + m * 16) * 512 + col0;
                const f32x4 g0 = acc[ai][0][m][0], g1 = acc[ai][0][m][1], u0 = acc[ai][1][m][0], u1 = acc[ai][1][m][1];
                u32x4 w; w.x = cvt_pk_bf16(silu_mul(g0[0], u0[0]), silu_mul(g0[1], u0[1])); w.y = cvt_pk_bf16(silu_mul(g0[2], u0[2]), silu_mul(g0[3], u0[3]));
                w.z = cvt_pk_bf16(silu_mul(g1[0], u1[0]), silu_mul(g1[1], u1[1])); w.w = cvt_pk_bf16(silu_mul(g1[2], u1[2]), silu_mul(g1[3], u1[3]));
                *(u32x4*)rowp = w; }
    }
};
struct EpiDown {
    static constexpr bool PERM = true, AFTER_DRAIN = false;
    bf16_t* Y; const int* list; const unsigned* cnt; const float* wgt;
    __device__ __forceinline__ void operator()(const f32x4 (&acc)[2][2][4][2], const Unit& u, int wr, int wc, int fr, int fq) const {
        const int e = u.aux >> 8, rt = u.aux & 255, n = (int)cnt[e];
        const int r0 = rt * BM + wr * 64 + fr, col0 = u.pn * BM + wc * 32 + 8 * fq;
#pragma unroll
        for (int ai = 0; ai < 2; ++ai)
#pragma unroll
            for (int m = 0; m < 4; ++m) { const int r = r0 + ai * HALF + m * 16;
                if (r < n) { const int a = list[(size_t)e * 16384 + r]; const float w = wgt[a]; bf16_t* rowp = Y + (size_t)a * 1024 + col0;
#pragma unroll
                    for (int bj = 0; bj < 2; ++bj) { const f32x4 v0 = acc[ai][bj][m][0] * w, v1 = acc[ai][bj][m][1] * w;
                        u32x4 o; o.x = cvt_pk_bf16(v0[0], v0[1]); o.y = cvt_pk_bf16(v0[2], v0[3]); o.z = cvt_pk_bf16(v1[0], v1[1]); o.w = cvt_pk_bf16(v1[2], v1[3]);
                        *(u32x4*)(rowp + bj * HALF) = o; } } }
    }
};

template <class Epi, class Sched, bool GATHER, bool ALIGN_EPI>
__device__ __forceinline__ void gemm_phase(PG8_LAS unsigned char* lds, const int K, const Sched& S, const Epi& E) {
    const int tid = threadIdx.x, wid = __builtin_amdgcn_readfirstlane(tid >> 6), lane = tid & 63, wr = wid >> 2, wc = wid & 3, fr = lane & 15, fq = lane >> 4;
    const int nt = K / BK;
    int RA[2], CA[2]; unsigned voffB[2];
#pragma unroll
    for (int i = 0; i < 2; ++i) { int R, C; stage_rc(tid * 16 + i * 8192, R, C); const int Rb = Epi::PERM ? ((R & ~31) + perm32(R & 31)) : R;
        RA[i] = R; CA[i] = C * 2; voffB[i] = (unsigned)(Rb * K + C) * 2u; }
    const size_t kstep = (size_t)(BK * 2);
    const size_t hstep = (size_t)HALF * K * 2;
    const unsigned ldsw = (unsigned)wid * 1024u;
    const int aoff = lds_byte(wr * 64 + fr, fq * 8), boff = lds_byte(wc * 32 + fr, fq * 8);
#define PG8_SA(b, h) (((b) * 2 + (h)) * HTB)
#define PG8_SB(b, h) ((4 + (b) * 2 + (h)) * HTB)
#define PG8_STAGE(bufoff, gbase, voff) do { _Pragma("unroll") for (int _i = 0; _i < 2; ++_i) \
        __builtin_amdgcn_global_load_lds((const unsigned*)((const char*)(gbase) + (voff)[_i]), (PG8_LAS unsigned*)(lds + (bufoff) + ldsw + _i * 8192), 16, 0, 0); } while (0)
#define PG8_LDA(dst, b, h) do { _Pragma("unroll") for (int m = 0; m < 4; ++m) _Pragma("unroll") for (int k = 0; k < 2; ++k) dst[m][k] = *(const PG8_LAS bf16x8*)(lds + PG8_SA(b, h) + aoff + m * 2048 + k * 1024); } while (0)
#define PG8_LDB(dst, b, h) do { _Pragma("unroll") for (int n = 0; n < 2; ++n) _Pragma("unroll") for (int k = 0; k < 2; ++k) dst[n][k] = *(const PG8_LAS bf16x8*)(lds + PG8_SB(b, h) + boff + n * 2048 + k * 1024); } while (0)
#define PG8_MMA(ai, bj, At, Bt) do { __builtin_amdgcn_s_setprio(1); _Pragma("unroll") for (int m = 0; m < 4; ++m) _Pragma("unroll") for (int n = 0; n < 2; ++n) _Pragma("unroll") for (int k = 0; k < 2; ++k) \
        acc[ai][bj][m][n] = __builtin_amdgcn_mfma_f32_16x16x32_bf16(Bt[n][k], At[m][k], acc[ai][bj][m][n], 0, 0, 0); __builtin_amdgcn_s_setprio(0); } while (0)
#define PG8_WAIT_V(n) asm volatile("s_waitcnt vmcnt(" #n ")" ::: "memory")
#define PG8_WAIT_L(n) asm volatile("s_waitcnt lgkmcnt(" #n ")" ::: "memory")
#define PG8_BAR __builtin_amdgcn_s_barrier()
#define PG8_SCHED __builtin_amdgcn_sched_barrier(0)
#define PG8_AOFFS(dst, u) do { _Pragma("unroll") for (int _h = 0; _h < 2; ++_h) _Pragma("unroll") for (int _i = 0; _i < 2; ++_i) dst[_h][_i] = S.a_off(u, RA[_i] + HALF * _h) + (unsigned)CA[_i]; } while (0)
    Unit cur, nxt; int ui = 0;
    if (!S.next(0, cur)) return;
    f32x4 acc[2][2][4][2];
#pragma unroll
    for (int a = 0; a < 2; ++a)
#pragma unroll
        for (int b = 0; b < 2; ++b)
#pragma unroll
            for (int m = 0; m < 4; ++m)
#pragma unroll
                for (int n = 0; n < 2; ++n) acc[a][b][m][n] = (f32x4){0.f, 0.f, 0.f, 0.f};
    bf16x8 At[4][2], B0[2][2], B1[2][2];
    unsigned vA[2][2], vN[2][2];
    PG8_AOFFS(vA, cur);
    const char* cA = S.a_base(cur); const char* cB = S.b_base(cur);
    PG8_STAGE(PG8_SB(0, 0), cB, voffB); PG8_STAGE(PG8_SB(0, 1), cB + hstep, voffB); PG8_STAGE(PG8_SA(0, 0), cA, vA[0]); PG8_STAGE(PG8_SA(0, 1), cA, vA[1]);
    if (wr == 1) PG8_BAR;
    PG8_WAIT_V(2); PG8_BAR;
    PG8_STAGE(PG8_SB(1, 0), cB + kstep, voffB); PG8_STAGE(PG8_SA(1, 0), cA + kstep, vA[0]); PG8_STAGE(PG8_SB(1, 1), cB + hstep + kstep, voffB);
    PG8_WAIT_V(6); PG8_BAR;
    for (;;) {
        const bool has_next = S.next(ui + 1, nxt);
        const char* nA = cA; const char* nB = cB;
        if (has_next) { nA = S.a_base(nxt); nB = S.b_base(nxt); }
        if (GATHER) { if (has_next) { PG8_AOFFS(vN, nxt); } else {
#pragma unroll
            for (int h = 0; h < 2; ++h)
#pragma unroll
                for (int i = 0; i < 2; ++i) vN[h][i] = vA[h][i]; } }
        for (int t = 0; t < nt; t += 2) {
            const bool last = (t == nt - 2);
            const char* a1 = cA + (size_t)(t + 1) * kstep;
            const char* a2 = last ? nA : cA + (size_t)(t + 2) * kstep; const char* b2 = last ? nB : cB + (size_t)(t + 2) * kstep;
            const char* a3 = a2 + kstep; const char* b3 = b2 + kstep;
            unsigned vS[2][2];
#pragma unroll
            for (int h = 0; h < 2; ++h)
#pragma unroll
                for (int i = 0; i < 2; ++i) vS[h][i] = (GATHER && last) ? vN[h][i] : vA[h][i];
            PG8_LDB(B0, 0, 0); PG8_LDB(B1, 0, 1); PG8_SCHED; PG8_LDA(At, 0, 0); PG8_STAGE(PG8_SA(1, 1), a1, vA[1]);
            PG8_WAIT_V(8); PG8_WAIT_L(0); PG8_BAR; PG8_MMA(0, 0, At, B0); PG8_MMA(0, 1, At, B1); PG8_BAR; PG8_SCHED;
            PG8_LDA(At, 0, 1); PG8_STAGE(PG8_SB(0, 0), b2, voffB); PG8_STAGE(PG8_SB(0, 1), b2 + hstep, voffB); PG8_STAGE(PG8_SA(0, 0), a2, vS[0]);
            PG8_WAIT_V(8); PG8_WAIT_L(0); PG8_BAR; PG8_MMA(1, 0, At, B0); PG8_MMA(1, 1, At, B1); PG8_BAR; PG8_SCHED;
            PG8_LDB(B0, 1, 0); PG8_LDB(B1, 1, 1); PG8_SCHED; PG8_LDA(At, 1, 0); PG8_STAGE(PG8_SA(0, 1), a2, vS[1]);
            PG8_WAIT_V(8); PG8_WAIT_L(0); PG8_BAR; PG8_MMA(0, 0, At, B0); PG8_MMA(0, 1, At, B1); PG8_BAR; PG8_SCHED;
            PG8_LDA(At, 1, 1); PG8_STAGE(PG8_SB(1, 0), b3, voffB); PG8_STAGE(PG8_SB(1, 1), b3 + hstep, voffB); PG8_STAGE(PG8_SA(1, 0), a3, vS[0]);
            PG8_WAIT_V(8); PG8_WAIT_L(0); PG8_BAR; PG8_MMA(1, 0, At, B0); PG8_MMA(1, 1, At, B1); PG8_BAR; PG8_SCHED;
        }
        if constexpr (ALIGN_EPI) { if (wr == 0) PG8_BAR; }
        E(acc, cur, wr, wc, fr, fq);
        if (!has_next) break;
#pragma unroll
        for (int a = 0; a < 2; ++a)
#pragma unroll
            for (int b = 0; b < 2; ++b)
#pragma unroll
                for (int m = 0; m < 4; ++m)
#pragma unroll
                    for (int n = 0; n < 2; ++n) acc[a][b][m][n] = (f32x4){0.f, 0.f, 0.f, 0.f};
        cur = nxt; cA = nA; cB = nB; ++ui;
        if (GATHER) {
#pragma unroll
            for (int h = 0; h < 2; ++h)
#pragma unroll
                for (int i = 0; i < 2; ++i) vA[h][i] = vN[h][i]; }
        if constexpr (ALIGN_EPI) { if (wr == 1) PG8_BAR; }
    }
    PG8_WAIT_V(0);
    if constexpr (!ALIGN_EPI) { if (wr == 0) PG8_BAR; }
    PG8_BAR;
#undef PG8_SA
#undef PG8_SB
#undef PG8_STAGE
#undef PG8_LDA
#undef PG8_LDB
#undef PG8_MMA
#undef PG8_WAIT_V
#undef PG8_WAIT_L
#undef PG8_BAR
#undef PG8_SCHED
#undef PG8_AOFFS
}
}

constexpr int NWAVES = 8;
constexpr size_t WS_WIN = 1 * MiB;
constexpr size_t WS_WOUT = 8 * MiB;
constexpr size_t WS_WGU = 42 * MiB;
constexpr size_t WS_WD = 106 * MiB;
constexpr size_t WS_ACT = 146 * MiB;
constexpr size_t WS_ROPE = 253 * MiB;
constexpr size_t WS_DEC = 254 * MiB;
constexpr int CW_BAR = 4096;
constexpr int RING_OFF = 0, RING_BYTES = 131072;
constexpr int TAB_OFF = 147456, MISC_OFF = TAB_OFF + 1024, LDS_BYTES = MISC_OFF + 256;

#define GAS __attribute__((address_space(1)))
#define LAS __attribute__((address_space(3)))
typedef unsigned v4u __attribute__((ext_vector_type(4)));
typedef unsigned v2u __attribute__((ext_vector_type(2)));
typedef float f32x4 __attribute__((ext_vector_type(4)));
typedef short bf16x8 __attribute__((ext_vector_type(8)));
typedef GAS unsigned gu32;
#define RLX_AGENT __ATOMIC_RELAXED, __HIP_MEMORY_SCOPE_AGENT
#define LDS_WAIT() asm volatile("s_waitcnt lgkmcnt(0)" ::: "memory")
#define VM_WAIT() asm volatile("s_waitcnt vmcnt(0)" ::: "memory")
__device__ __forceinline__ unsigned pk2(float lo, float hi) { return (unsigned)f2bf(lo) | ((unsigned)f2bf(hi) << 16); }

#define XB_TMO      128
#define XB_XCNT(j)  (256  + 64 * (j))
#define XB_XSUB(j)  (1280 + 64 * (j))
#define XB_XGEN(j)  (2304 + 64 * (j))
#define XB_TOP      3328
#define XB_TOPGEN   3392
#define XCD_BAR_WORDS 3456
#define XB_SPIN_CAP (1u << 18)

__device__ __forceinline__ unsigned xb_ld(unsigned* p)              { return __hip_atomic_load(p, __ATOMIC_RELAXED, __HIP_MEMORY_SCOPE_AGENT); }
__device__ __forceinline__ unsigned xb_add(unsigned* p, unsigned v) { return __hip_atomic_fetch_add(p, v, __ATOMIC_RELAXED, __HIP_MEMORY_SCOPE_AGENT); }
__device__ __forceinline__ unsigned xb_xcc_id() { return (unsigned)__builtin_amdgcn_s_getreg((3 << 11) | 20) & 0xFu; }
#define XB_SPIN(cond, bar) do { unsigned _sp = 0; while (cond) { __builtin_amdgcn_s_sleep(1); \
    if ((++_sp & 255u) == 0u) { if (xb_ld(&(bar)[XB_TMO])) break; if (_sp > XB_SPIN_CAP) { atomicAdd(&(bar)[XB_TMO], 1u); break; } } } } while (0)

struct XcdBarrier {
    unsigned* bar; unsigned x;
    volatile LAS unsigned* st;
};
__device__ __forceinline__ XcdBarrier xcd_barrier_post(unsigned* bar, volatile LAS unsigned* st) {
    XcdBarrier b; b.bar = bar; b.x = xb_xcc_id(); b.st = st;
    if (threadIdx.x == 0) (void)xb_add(&bar[XB_XCNT(b.x)], 1u);
    return b;
}
__device__ __forceinline__ void xcd_barrier_complete(unsigned* bar, unsigned x, unsigned& nloc, unsigned& nx) {
    const unsigned G = gridDim.x * gridDim.y * gridDim.z;
    unsigned sum, cnt, mine, sp = 0u;
    for (;;) {
        sum = 0u; cnt = 0u; mine = 0u;
#pragma unroll
        for (unsigned j = 0; j < 16; ++j) { const unsigned c = xb_ld(&bar[XB_XCNT(j)]); sum += c; cnt += (c > 0u) ? 1u : 0u; mine = (j == x) ? c : mine; }
        if (sum == G) break;
        __builtin_amdgcn_s_sleep(1);
        if ((++sp & 255u) == 0u) { if (xb_ld(&bar[XB_TMO])) break; if (sp > XB_SPIN_CAP) { atomicAdd(&bar[XB_TMO], 1u); break; } }
    }
    nloc = mine > 0u ? mine : 1u; nx = cnt > 0u ? cnt : 1u;
}
__device__ __forceinline__ void xcd_barrier(const XcdBarrier& b) {
    asm volatile("s_waitcnt vmcnt(0)" ::: "memory");
    __syncthreads();
    if (threadIdx.x == 0) {
        unsigned* bar = b.bar;
        __builtin_amdgcn_s_waitcnt(0);
        unsigned nloc = b.st[0], nx = b.st[1];
        if (nloc == 0u) { xcd_barrier_complete(bar, b.x, nloc, nx); b.st[0] = nloc; b.st[1] = nx; }
        const unsigned old = xb_add(&bar[XB_XSUB(b.x)], 1u);
        const unsigned gen = old / nloc;
        if (old + 1u == (gen + 1u) * nloc) {
            __builtin_amdgcn_fence(__ATOMIC_RELEASE, "agent");
            asm volatile("s_waitcnt vmcnt(0)" ::: "memory");
            const unsigned og = xb_add(&bar[XB_TOP], 1u);
            const unsigned tg = og / nx;
            if (og + 1u == (tg + 1u) * nx) xb_add(&bar[XB_TOPGEN], 1u);
            else XB_SPIN(xb_ld(&bar[XB_TOPGEN]) == tg, bar);
            __builtin_amdgcn_fence(__ATOMIC_ACQUIRE, "agent");
            xb_add(&bar[XB_XGEN(b.x)], 1u);
            asm volatile("s_waitcnt vmcnt(0)" ::: "memory");
        } else {
            XB_SPIN(xb_ld(&bar[XB_XGEN(b.x)]) == gen, bar);
            __builtin_amdgcn_fence(__ATOMIC_ACQUIRE, "agent");
            asm volatile("s_waitcnt vmcnt(0)" ::: "memory");
        }
    }
    __syncthreads();
}

struct Frame {
    LAS unsigned char* lds;
    volatile LAS unsigned* MISC;
    gu32* ctl;
    int tid, lane, wave;
    int vcu, G;
    const float* in[18]; float* out; unsigned char* ws;
};

__device__ __forceinline__ void transpose_item(const float* W, int ldw, int k0, int n0, bf16* WT, int ldt, int row0, LAS float* scr, int lane) {
#pragma unroll 8
    for (int i = 0; i < 32; ++i) { const int kk = 2 * i + (lane >> 5); scr[kk * 33 + (lane & 31)] = W[(size_t)(k0 + kk) * ldw + n0 + (lane & 31)]; }
    LDS_WAIT(); asm volatile("" ::: "memory");
    const int c = lane & 7;
#pragma unroll
    for (int j = 0; j < 4; ++j) { const int n = (lane >> 3) + 8 * j; const LAS float* s = scr + (8 * c) * 33 + n;
        v4u o; o.x = pk2(s[0 * 33], s[1 * 33]); o.y = pk2(s[2 * 33], s[3 * 33]); o.z = pk2(s[4 * 33], s[5 * 33]); o.w = pk2(s[6 * 33], s[7 * 33]);
        *(GAS v4u*)(WT + (size_t)(row0 + n) * ldt + k0 + 8 * c) = o; }
    LDS_WAIT(); asm volatile("" ::: "memory");
}
__device__ __forceinline__ void rms_row_to_bf16(const float* xrow, const float* w, bf16* orow, int lane) {
    const GAS f32x4* xr = (const GAS f32x4*)xrow + lane;
    f32x4 v[4]; float s = 0.f;
#pragma unroll
    for (int j = 0; j < 4; ++j) { v[j] = xr[64 * j]; s += (v[j].x * v[j].x + v[j].y * v[j].y) + (v[j].z * v[j].z + v[j].w * v[j].w); }
    const float rstd = rsqrtf(wave_sum(s) * (1.f / D) + 1e-6f);
    GAS v2u* o8 = (GAS v2u*)orow + lane;
#pragma unroll
    for (int j = 0; j < 4; ++j) { const f32x4 ww = ((const GAS f32x4*)w)[lane + 64 * j]; v2u o; o.x = pk2(v[j].x * rstd * ww.x, v[j].y * rstd * ww.y); o.y = pk2(v[j].z * rstd * ww.z, v[j].w * rstd * ww.w); o8[64 * j] = o; }
}

__device__ __forceinline__ void p0_prologue(Frame& F) {
    LAS float* scr = (LAS float*)(F.lds + RING_OFF + F.wave * 16384);
    const int gw = F.vcu * NWAVES + F.wave, NGW = F.G * NWAVES;
    bf16* WIN = (bf16*)(F.ws + WS_WIN); bf16* WOUT = (bf16*)(F.ws + WS_WOUT);
    constexpr int I_IN = 16 * 97, I_OUT = 16 * 32;
    for (int it = gw; it < I_IN + I_OUT; it += NGW) {
        if (it < I_IN) { const int kb = it / 97, nb = it % 97; const int n0 = nb * 32;
            const int src = n0 < 1536 ? n0 : (n0 < 3072 ? n0 + 32 : n0 - 1536);
            transpose_item(F.in[2], INW, kb * 64, src, WIN, D, n0, scr, F.lane); }
        else { const int r = it - I_IN, kb = r / 32, nb = r % 32; transpose_item(F.in[8], D, kb * 64, nb * 32, WOUT, D, nb * 32, scr, F.lane); }
    }
    { GAS v4u* z = (GAS v4u*)(WIN + (size_t)INW * D); const int n16 = (PP - INW) * D * 2 / 16;
      for (int i = blockIdx.x * 512 + F.tid; i < n16; i += F.G * 512) z[i] = (v4u){0u, 0u, 0u, 0u}; }
    { float* rope = (float*)(F.ws + WS_ROPE);
      for (int i = blockIdx.x * 512 + F.tid; i < SEQ * 8; i += F.G * 512) { const int pos = i >> 3, j = i & 7;
          const double inv = exp2(-(double)j * 0.125 * 18.931568569324174);
          double r = (double)pos * inv * 0.15915494309189535; r -= floor(r);
          const float a = (float)(r * 6.283185307179586);
          rope[pos * 16 + j] = cosf(a); rope[pos * 16 + 8 + j] = sinf(a); } }
    bf16* U = (bf16*)(F.ws + WS_U);
    for (int m = gw; m < T; m += NGW) rms_row_to_bf16(F.in[0] + (size_t)m * D, F.in[1], U + (size_t)m * D, F.lane);
}

__device__ __forceinline__ void p6_router(Frame& F, const bool dry) {
    LAS float* WGt = (LAS float*)(F.lds);
    LAS float* WEt = (LAS float*)(F.lds + 16384);
    LAS unsigned* hist = (LAS unsigned*)(F.lds + TAB_OFF);
    LAS unsigned* base = hist + 32;
    LAS unsigned* sel = hist + 64;
    for (int k = F.tid; k < 1024; k += 512) { const f32x4 w = ((const GAS f32x4*)F.in[10])[k]; WGt[k] = w.x; WGt[1024 + k] = w.y; WGt[2048 + k] = w.z; WGt[3072 + k] = w.w; }
    for (int i = F.tid; i < 4096; i += 512) { const f32x4 a = ((const GAS f32x4*)F.in[12])[2 * i], b = ((const GAS f32x4*)F.in[12])[2 * i + 1];
        LAS float* p = WEt + (i >> 10) * 8192 + (i & 1023);
        p[0] = a.x; p[1024] = a.y; p[2048] = a.z; p[3072] = a.w; p[4096] = b.x; p[5120] = b.y; p[6144] = b.z; p[7168] = b.w; }
    const int lane = F.lane, w = F.wave;
    bf16* U = (bf16*)(F.ws + WS_U); unsigned* CNT = (unsigned*)(F.ctl + CW_CNT); int* LIST = (int*)(F.ws + WS_LIST); float* WGT = (float*)(F.ws + WS_WGT);
    const float* nw = F.in[9]; const float* bg = F.in[11]; const float* be = F.in[13];
    for (int rb = blockIdx.x; rb < T / 64; rb += F.G) {
        if (F.tid < 32) hist[F.tid] = 0u;
        __syncthreads();
        v2u hraw[8][4];
#pragma unroll
        for (int i = 0; i < 8; ++i) { const GAS v2u* hp = (const GAS v2u*)((const bf16*)(F.ws + WS_H1) + (size_t)(rb * 64 + w * 8 + i) * D) + lane;
#pragma unroll
            for (int j = 0; j < 4; ++j) hraw[i][j] = hp[64 * j]; }
#pragma unroll
        for (int i = 0; i < 8; ++i) {
            const int rl = w * 8 + i, row = rb * 64 + rl;
            f32x4 v[4]; float s = 0.f;
#pragma unroll
            for (int j = 0; j < 4; ++j) { const v2u h = hraw[i][j]; v[j] = (f32x4){__uint_as_float(h.x << 16), __uint_as_float(h.x & 0xffff0000u), __uint_as_float(h.y << 16), __uint_as_float(h.y & 0xffff0000u)};
                s += (v[j].x * v[j].x + v[j].y * v[j].y) + (v[j].z * v[j].z + v[j].w * v[j].w); }
            const float rstd = rsqrtf(wave_sum(s) * (1.f / D) + 1e-6f);
            GAS v2u* o8 = (GAS v2u*)(U + (size_t)row * D) + lane;
#pragma unroll
            for (int j = 0; j < 4; ++j) { const f32x4 ww = ((const GAS f32x4*)nw)[lane + 64 * j]; v[j].x *= rstd * ww.x; v[j].y *= rstd * ww.y; v[j].z *= rstd * ww.z; v[j].w *= rstd * ww.w;
                v2u o; o.x = pk2(v[j].x, v[j].y); o.y = pk2(v[j].z, v[j].w); o8[64 * j] = o; }
            float gl[4];
#pragma unroll
            for (int g = 0; g < 4; ++g) { float a = 0.f;
#pragma unroll
                for (int j = 0; j < 4; ++j) { const f32x4 w4 = *(const LAS f32x4*)(WGt + g * 1024 + 4 * (lane + 64 * j)); a += (w4.x * v[j].x + w4.y * v[j].y) + (w4.z * v[j].z + w4.w * v[j].w); }
                gl[g] = wave_sum(a) + bg[g]; }
            int gs = 0; float gm = gl[0];
#pragma unroll
            for (int g = 1; g < 4; ++g) if (gl[g] > gm) { gm = gl[g]; gs = g; }
            const float gw_ = 1.f / (expf(gl[0] - gm) + expf(gl[1] - gm) + expf(gl[2] - gm) + expf(gl[3] - gm));
            gs = __builtin_amdgcn_readfirstlane(gs);
            float el[8];
#pragma unroll
            for (int e = 0; e < 8; ++e) { float a = 0.f;
#pragma unroll
                for (int j = 0; j < 4; ++j) { const f32x4 w4 = *(const LAS f32x4*)(WEt + (gs * 8 + e) * 1024 + 4 * (lane + 64 * j)); a += (w4.x * v[j].x + w4.y * v[j].y) + (w4.z * v[j].z + w4.w * v[j].w); }
                el[e] = wave_sum(a) + be[gs * 8 + e]; }
            int i0 = 0; float v0 = el[0];
#pragma unroll
            for (int e = 1; e < 8; ++e) if (el[e] > v0) { v0 = el[e]; i0 = e; }
            int i1 = -1; float v1 = -3.0e38f;
#pragma unroll
            for (int e = 0; e < 8; ++e) if (e != i0 && el[e] > v1) { v1 = el[e]; i1 = e; }
            const float ee = expf(v1 - v0), w0 = gw_ / (1.f + ee), w1 = gw_ * ee / (1.f + ee);
            if (lane == 0) {
                const unsigned ex0 = (unsigned)(gs * 8 + i0), ex1 = (unsigned)(gs * 8 + i1);
                const unsigned r0 = __hip_atomic_fetch_add(hist + ex0, 1u, __ATOMIC_RELAXED, __HIP_MEMORY_SCOPE_WORKGROUP);
                const unsigned r1 = __hip_atomic_fetch_add(hist + ex1, 1u, __ATOMIC_RELAXED, __HIP_MEMORY_SCOPE_WORKGROUP);
                sel[rl * 2] = ex0 | (r0 << 8); sel[rl * 2 + 1] = ex1 | (r1 << 8);
                WGT[row * 2] = w0; WGT[row * 2 + 1] = w1;
            }
        }
        __syncthreads();
        if (F.tid < 32) { const unsigned hv = hist[F.tid]; base[F.tid] = (hv && !dry) ? atomicAdd(CNT + F.tid, hv) : 0u; }
        __syncthreads();
        if (F.tid < 128 && !dry) { const unsigned sv = sel[F.tid], e = sv & 255u, rank = sv >> 8;
            LIST[(size_t)e * T + base[e] + rank] = (rb * 64 + (F.tid >> 1)) * 2 + (F.tid & 1); }
    }
}
__device__ __forceinline__ void p6_convert(Frame& F) {
    const int gw = F.vcu * NWAVES + F.wave, NGW = F.G * NWAVES, lane = F.lane;
    __syncthreads();
    LAS float* scr = (LAS float*)(F.lds + RING_OFF + F.wave * 16384);
    bf16* WGU = (bf16*)(F.ws + WS_WGU); bf16* WD = (bf16*)(F.ws + WS_WD);
    for (int it = gw; it < 32 * 768; it += NGW) {
        const int e = it / 768, r = it % 768;
        if (r < 512) { const int gu = r >> 8, q = r & 255, kb = q >> 4, nb = q & 15, n0 = nb * 32;
            transpose_item((gu ? F.in[15] : F.in[14]) + (size_t)e * 1024 * 512, 512, kb * 64, n0, WGU + (size_t)e * 1024 * 1024, 1024, (n0 >> 7) * 256 + gu * 128 + (n0 & 127), scr, lane); }
        else { const int q = r - 512, kb = q >> 5, nb = q & 31;
            transpose_item(F.in[16] + (size_t)e * 512 * 1024, 1024, kb * 64, nb * 32, WD + (size_t)e * 1024 * 512, 512, nb * 32, scr, lane); }
    }
}

__device__ __forceinline__ void p9_final(Frame& F, float* dst) {
    const int gw = F.vcu * NWAVES + F.wave, NGW = F.G * NWAVES, lane = F.lane;
    const bf16* Y = (const bf16*)(F.ws + WS_YBUF); const bf16* H = (const bf16*)(F.ws + WS_H1); const float* w = F.in[17];
    for (int row0 = gw; row0 < T; row0 += 2 * NGW) {
        v2u hh[2][4], ya[2][4], yb[2][4];
#pragma unroll
        for (int r = 0; r < 2; ++r) { const int row = row0 + r * NGW;
            const GAS v2u* hp = (const GAS v2u*)(H + (size_t)row * D) + lane;
            const GAS v2u* y0 = (const GAS v2u*)(Y + (size_t)(2 * row) * D) + lane; const GAS v2u* y1 = (const GAS v2u*)(Y + (size_t)(2 * row + 1) * D) + lane;
#pragma unroll
            for (int j = 0; j < 4; ++j) { hh[r][j] = hp[64 * j]; ya[r][j] = y0[64 * j]; yb[r][j] = y1[64 * j]; } }
#pragma unroll
        for (int r = 0; r < 2; ++r) { const int row = row0 + r * NGW;
            GAS f32x4* xw = (GAS f32x4*)(dst + (size_t)row * D) + lane;
            f32x4 v[4]; float s = 0.f;
#pragma unroll
            for (int j = 0; j < 4; ++j) { const v2u h = hh[r][j], a = ya[r][j], b = yb[r][j];
                v[j].x = __uint_as_float(h.x << 16) + __uint_as_float(a.x << 16) + __uint_as_float(b.x << 16); v[j].y = __uint_as_float(h.x & 0xffff0000u) + __uint_as_float(a.x & 0xffff0000u) + __uint_as_float(b.x & 0xffff0000u);
                v[j].z = __uint_as_float(h.y << 16) + __uint_as_float(a.y << 16) + __uint_as_float(b.y << 16); v[j].w = __uint_as_float(h.y & 0xffff0000u) + __uint_as_float(a.y & 0xffff0000u) + __uint_as_float(b.y & 0xffff0000u);
                s += (v[j].x * v[j].x + v[j].y * v[j].y) + (v[j].z * v[j].z + v[j].w * v[j].w); }
            const float rstd = rsqrtf(wave_sum(s) * (1.f / D) + 1e-6f);
#pragma unroll
            for (int j = 0; j < 4; ++j) { const f32x4 ww = ((const GAS f32x4*)w)[lane + 64 * j]; __builtin_nontemporal_store((f32x4){v[j].x * rstd * ww.x, v[j].y * rstd * ww.y, v[j].z * rstd * ww.z, v[j].w * rstd * ww.w}, (f32x4*)(xw + 64 * j)); }
        }
    }
}

__device__ __forceinline__ int moe_build_tab(Frame& F) {
    LAS int* tab = (LAS int*)(F.lds + TAB_OFF);
    if (F.tid == 0) { const unsigned* CNT = (const unsigned*)(F.ctl + CW_CNT); int R = 0;
        for (int e = 0; e < 32; ++e) { const int nt = ((int)CNT[e] + 255) >> 8; for (int rt = 0; rt < nt && R < 255; ++rt) tab[R++] = (e << 8) | rt; }
        tab[255] = R; }
    __syncthreads();
    const int NT = tab[255];
    return __builtin_amdgcn_readfirstlane(NT);
}


typedef float f32x2_t __attribute__((ext_vector_type(2))); typedef __bf16 bf16x2_t __attribute__((ext_vector_type(2)));
__device__ __forceinline__ unsigned cvtpk(float lo, float hi) { f32x2_t v = {lo, hi}; bf16x2_t b = __builtin_convertvector(v, bf16x2_t); return __builtin_bit_cast(unsigned, b); }
namespace att {
typedef short s16x4 __attribute__((ext_vector_type(4)));
typedef short v4i16_t __attribute__((ext_vector_type(4)));
constexpr int KOFF = 0, VOFF = 49152, QOFF = 98304;
constexpr float QSCALE = 0.125f * 1.4426950408889634f;
__device__ __forceinline__ int swz_off(int r, int ch) { return r * 128 + ((ch ^ ((r >> 1) & 7)) << 4); }
__device__ __forceinline__ s16x4 vtr(const LAS unsigned char* p) { return __builtin_bit_cast(s16x4, __builtin_amdgcn_ds_read_tr16_b64_v4i16((LAS v4i16_t*)p)); }
__device__ __forceinline__ float blo(unsigned u) { return __uint_as_float(u << 16); }
__device__ __forceinline__ float bhi(unsigned u) { return __uint_as_float(u & 0xffff0000u); }

__device__ __forceinline__ void rope16(v4u& a, v4u& b, const float* rp, float sc) {
    const f32x4 c0 = *(const GAS f32x4*)rp, c1 = *(const GAS f32x4*)(rp + 4), s0 = *(const GAS f32x4*)(rp + 8), s1 = *(const GAS f32x4*)(rp + 12);
    const float cs[8] = {c0.x, c0.y, c0.z, c0.w, c1.x, c1.y, c1.z, c1.w}, sn[8] = {s0.x, s0.y, s0.z, s0.w, s1.x, s1.y, s1.z, s1.w};
    float t1[8], t2[8];
#pragma unroll
    for (int i = 0; i < 4; ++i) { t1[2 * i] = blo(a[i]); t1[2 * i + 1] = bhi(a[i]); t2[2 * i] = blo(b[i]); t2[2 * i + 1] = bhi(b[i]); }
#pragma unroll
    for (int i = 0; i < 4; ++i) {
        a[i] = pk2((t1[2 * i] * cs[2 * i] - t2[2 * i] * sn[2 * i]) * sc, (t1[2 * i + 1] * cs[2 * i + 1] - t2[2 * i + 1] * sn[2 * i + 1]) * sc);
        b[i] = pk2((t2[2 * i] * cs[2 * i] + t1[2 * i] * sn[2 * i]) * sc, (t2[2 * i + 1] * cs[2 * i + 1] + t1[2 * i + 1] * sn[2 * i + 1]) * sc);
    }
}
__device__ __forceinline__ void scale16(v4u& a, v4u& b, float sc) {
#pragma unroll
    for (int i = 0; i < 4; ++i) { a[i] = pk2(blo(a[i]) * sc, bhi(a[i]) * sc); b[i] = pk2(blo(b[i]) * sc, bhi(b[i]) * sc); }
}

struct AUnit { int p, b, h, d, dl, L, c, i0; };
__device__ __forceinline__ AUnit attn_decode(int bh, int rem) {
    AUnit a; a.b = bh >> 3; a.h = bh & 7; a.p = rem >> 5; const int cj = rem & 31;
    a.dl = 2 * a.p; a.d = 1 << a.dl; a.L = SEQ >> a.dl; const int nb = a.L >> 8;
    a.c = cj / nb; a.i0 = (cj - a.c * nb) * 256; return a;
}
__device__ __forceinline__ void attn_load(const Frame& F, const AUnit& a, v4u (&kr)[6], v4u (&vr)[6], bf16x8 (&qf)[2][2]) {
    const bf16* proj = (const bf16*)(F.ws + WS_PROJ);
#pragma unroll
    for (int it = 0; it < 6; ++it) { const int ct = F.tid + 512 * it, r = ct >> 3, ch = ct & 7, i = a.i0 - 64 + r;
        if (i >= 0 && i < a.L) { const bf16* src = proj + (size_t)(a.b * SEQ + i * a.d + a.c) * PP + a.h * 64 + ch * 8;
            kr[it] = *(const GAS v4u*)(src + C_AK); vr[it] = *(const GAS v4u*)(src + C_AV); }
        else { kr[it] = (v4u){0u, 0u, 0u, 0u}; vr[it] = (v4u){0u, 0u, 0u, 0u}; } }
    const int fr = F.lane & 15, g = F.lane >> 4;
#pragma unroll
    for (int tt = 0; tt < 2; ++tt) { const bf16* src = proj + (size_t)(a.b * SEQ + (a.i0 + 32 * F.wave + 16 * tt + fr) * a.d + a.c) * PP + C_AQ + a.h * 64 + 8 * g;
#pragma unroll
        for (int s = 0; s < 2; ++s) qf[tt][s] = *(const GAS bf16x8*)(src + 32 * s); }
}
__device__ __forceinline__ void attn_store(const Frame& F, const v4u (&kr)[6], const v4u (&vr)[6]) {
#pragma unroll
    for (int it = 0; it < 6; ++it) { const int ct = F.tid + 512 * it, r = ct >> 3, ch = ct & 7;
        *(LAS v4u*)(F.lds + KOFF + swz_off(r, ch)) = kr[it]; *(LAS v4u*)(F.lds + VOFF + swz_off(r, ch)) = vr[it]; }
}
__device__ __forceinline__ void attn_compute(const Frame& F, const AUnit& a, const bf16x8 (&qf)[2][2]) {
    LAS unsigned char* lds = F.lds; const int lane = F.lane, w = F.wave;
    const int fr = lane & 15, g = lane >> 4, q4 = fr >> 2, p4 = fr & 3;
    bf16* opart = (bf16*)(F.ws + WS_PART) + (size_t)a.p * T * 512;
    float* lse = (float*)(F.ws + WS_PART + (size_t)48 * MiB) + (size_t)a.p * T * 8;
    f32x4 s0[10], s1[10];
#pragma unroll
    for (int ut = 0; ut < 10; ++ut) {
        bf16x8 kf[2];
#pragma unroll
        for (int s = 0; s < 2; ++s) kf[s] = *(const LAS bf16x8*)(lds + KOFF + swz_off(32 * w + 16 * ut + fr, 4 * s + g));
        if (ut <= 8) { s0[ut] = (f32x4){0.f, 0.f, 0.f, 0.f};
#pragma unroll
            for (int s = 0; s < 2; ++s) s0[ut] = __builtin_amdgcn_mfma_f32_16x16x32_bf16(kf[s], qf[0][s], s0[ut], 0, 0, 0); }
        if (ut >= 1) { s1[ut] = (f32x4){0.f, 0.f, 0.f, 0.f};
#pragma unroll
            for (int s = 0; s < 2; ++s) s1[ut] = __builtin_amdgcn_mfma_f32_16x16x32_bf16(kf[s], qf[1][s], s1[ut], 0, 0, 0); }
    }
#pragma unroll
    for (int i = 0; i < 4; ++i) { const bool ge = (4 * g + i >= fr), le = (4 * g + i <= fr);
        s0[0][i] = ge ? s0[0][i] : -INFINITY; s0[8][i] = le ? s0[8][i] : -INFINITY;
        s1[1][i] = ge ? s1[1][i] : -INFINITY; s1[9][i] = le ? s1[9][i] : -INFINITY; }
    const bool front = (a.i0 == 0), back = (a.i0 + 256 == a.L);
    if (front || back) {
        const int lo = front ? 64 : 0, hi = back ? 320 : 1024, kb = 32 * w + 4 * g;
#pragma unroll
        for (int ut = 0; ut < 10; ++ut)
#pragma unroll
            for (int i = 0; i < 4; ++i) { const int ku = kb + 16 * ut + i; const bool ok = (ku >= lo) && (ku < hi);
                if (ut <= 8) s0[ut][i] = ok ? s0[ut][i] : -INFINITY;
                if (ut >= 1) s1[ut][i] = ok ? s1[ut][i] : -INFINITY; }
    }
    float m0 = -INFINITY, m1 = -INFINITY;
#pragma unroll
    for (int ut = 0; ut < 9; ++ut)
#pragma unroll
        for (int i = 0; i < 4; ++i) { m0 = fmaxf(m0, s0[ut][i]); m1 = fmaxf(m1, s1[ut + 1][i]); }
    m0 = fmaxf(m0, __shfl_xor(m0, 16)); m0 = fmaxf(m0, __shfl_xor(m0, 32));
    m1 = fmaxf(m1, __shfl_xor(m1, 16)); m1 = fmaxf(m1, __shfl_xor(m1, 32));
    float l0 = 0.f, l1 = 0.f;
#pragma unroll
    for (int ut = 0; ut < 9; ++ut)
#pragma unroll
        for (int i = 0; i < 4; ++i) { s0[ut][i] = __builtin_amdgcn_exp2f(s0[ut][i] - m0); l0 += s0[ut][i]; s1[ut + 1][i] = __builtin_amdgcn_exp2f(s1[ut + 1][i] - m1); l1 += s1[ut + 1][i]; }
    s0[9] = (f32x4){0.f, 0.f, 0.f, 0.f}; s1[0] = (f32x4){0.f, 0.f, 0.f, 0.f};
    l0 += __shfl_xor(l0, 16); l0 += __shfl_xor(l0, 32); l1 += __shfl_xor(l1, 16); l1 += __shfl_xor(l1, 32);
    f32x4 o0[4], o1[4];
#pragma unroll
    for (int vt = 0; vt < 4; ++vt) { o0[vt] = (f32x4){0.f, 0.f, 0.f, 0.f}; o1[vt] = (f32x4){0.f, 0.f, 0.f, 0.f}; }
#pragma unroll
    for (int kp = 0; kp < 5; ++kp) {
        v4u pw; pw.x = cvtpk(s0[2 * kp][0], s0[2 * kp][1]); pw.y = cvtpk(s0[2 * kp][2], s0[2 * kp][3]); pw.z = cvtpk(s0[2 * kp + 1][0], s0[2 * kp + 1][1]); pw.w = cvtpk(s0[2 * kp + 1][2], s0[2 * kp + 1][3]);
        const bf16x8 pf0 = __builtin_bit_cast(bf16x8, pw);
        pw.x = cvtpk(s1[2 * kp][0], s1[2 * kp][1]); pw.y = cvtpk(s1[2 * kp][2], s1[2 * kp][3]); pw.z = cvtpk(s1[2 * kp + 1][0], s1[2 * kp + 1][1]); pw.w = cvtpk(s1[2 * kp + 1][2], s1[2 * kp + 1][3]);
        const bf16x8 pf1 = __builtin_bit_cast(bf16x8, pw);
        const int r0 = 32 * w + 32 * kp + 4 * g + q4, r1 = r0 + 16;
#pragma unroll
        for (int vt = 0; vt < 4; ++vt) {
            const s16x4 a0 = vtr(lds + VOFF + swz_off(r0, 2 * vt + (p4 >> 1)) + 8 * (p4 & 1));
            const s16x4 a1 = vtr(lds + VOFF + swz_off(r1, 2 * vt + (p4 >> 1)) + 8 * (p4 & 1));
            const bf16x8 af = __builtin_shufflevector(a0, a1, 0, 1, 2, 3, 4, 5, 6, 7);
            o0[vt] = __builtin_amdgcn_mfma_f32_16x16x32_bf16(af, pf0, o0[vt], 0, 0, 0);
            o1[vt] = __builtin_amdgcn_mfma_f32_16x16x32_bf16(af, pf1, o1[vt], 0, 0, 0);
        }
    }
    const float inv0 = 1.0f / l0, inv1 = 1.0f / l1;
    const size_t tok0 = (size_t)a.b * SEQ + (size_t)(a.i0 + 32 * w + fr) * a.d + a.c, tok1 = tok0 + (size_t)16 * a.d;
#pragma unroll
    for (int vt = 0; vt < 4; ++vt) { v2u ov; ov.x = cvtpk(o0[vt][0] * inv0, o0[vt][1] * inv0); ov.y = cvtpk(o0[vt][2] * inv0, o0[vt][3] * inv0);
        *(GAS v2u*)(opart + tok0 * 512 + a.h * 64 + 16 * vt + 4 * g) = ov;
        ov.x = cvtpk(o1[vt][0] * inv1, o1[vt][1] * inv1); ov.y = cvtpk(o1[vt][2] * inv1, o1[vt][3] * inv1);
        *(GAS v2u*)(opart + tok1 * 512 + a.h * 64 + 16 * vt + 4 * g) = ov; }
    if (g == 0) { lse[tok0 * 8 + a.h] = m0 + __builtin_amdgcn_logf(l0); lse[tok1 * 8 + a.h] = m1 + __builtin_amdgcn_logf(l1); }
}
__device__ __forceinline__ void attn_phase(Frame& F) {
    const int G = F.G;
    int xcd, j, nj;
    if ((G & 7) == 0) { xcd = blockIdx.x & 7; j = blockIdx.x >> 3; nj = G >> 3; } else { xcd = 0; j = blockIdx.x; nj = G; }
    const int nx = ((G & 7) == 0) ? 8 : 1, per = 1536 / nx;
    v4u kr[6], vr[6]; bf16x8 qn[2][2];
    int k = j;
    if (k < per) { const int gu = xcd * per + k; const AUnit a = attn_decode(gu / 96, gu % 96); attn_load(F, a, kr, vr, qn); }
    for (; k < per; k += nj) {
        const int gu = xcd * per + k; const AUnit a = attn_decode(gu / 96, gu % 96);
        attn_store(F, kr, vr);
        bf16x8 qc[2][2];
#pragma unroll
        for (int tt = 0; tt < 2; ++tt)
#pragma unroll
            for (int s = 0; s < 2; ++s) qc[tt][s] = qn[tt][s];
        __syncthreads();
        if (k + nj < per) { const int gn = xcd * per + k + nj; const AUnit an = attn_decode(gn / 96, gn % 96); attn_load(F, an, kr, vr, qn); }
        attn_compute(F, a, qc);
        __syncthreads();
    }
}

__device__ __forceinline__ void attn_merge(Frame& F) {
    const bf16* opart = (const bf16*)(F.ws + WS_PART); const float* lse = (const float*)(F.ws + WS_PART + (size_t)48 * MiB);
    bf16* mixed = (bf16*)(F.ws + WS_U);
    for (int task = blockIdx.x * 512 + F.tid; task < T * 64; task += F.G * 512) {
        const int tok = task >> 6, hc = task & 63, h = hc >> 3;
        const float l0 = lse[(size_t)tok * 8 + h], l1 = lse[(size_t)T * 8 + (size_t)tok * 8 + h], l2 = lse[(size_t)2 * T * 8 + (size_t)tok * 8 + h];
        const float mx = fmaxf(l0, fmaxf(l1, l2));
        float w0 = __builtin_amdgcn_exp2f(l0 - mx), w1 = __builtin_amdgcn_exp2f(l1 - mx), w2 = __builtin_amdgcn_exp2f(l2 - mx);
        const float inv = 1.0f / (w0 + w1 + w2); w0 *= inv; w1 *= inv; w2 *= inv;
        const size_t off = (size_t)tok * 512 + hc * 8;
        const v4u a = *(const GAS v4u*)(opart + off), bq = *(const GAS v4u*)(opart + (size_t)T * 512 + off), cq = *(const GAS v4u*)(opart + (size_t)2 * T * 512 + off);
        v4u o;
#pragma unroll
        for (int i = 0; i < 4; ++i) o[i] = pk2(w0 * blo(a[i]) + w1 * blo(bq[i]) + w2 * blo(cq[i]), w0 * bhi(a[i]) + w1 * bhi(bq[i]) + w2 * bhi(cq[i]));
        *(GAS v4u*)(mixed + (size_t)tok * D + 512 + hc * 8) = o;
    }
}
}


namespace gla {
using att::s16x4; using att::vtr; using att::blo; using att::bhi;
constexpr int IMG = 0, VIMG = 32768, LRO = 49152, SEG = 57344, SSQ = 59392;
__device__ __forceinline__ int swz64(int r, int ch) { return r * 128 + ((ch ^ ((r >> 1) & 7)) << 4); }
__device__ __forceinline__ int swzV(int r, int ch) { return r * 256 + ((ch ^ ((r & 7) << 1)) << 4); }
__device__ __forceinline__ float fexp(float x) { return __builtin_amdgcn_exp2f(x * 1.4426950408889634f); }

template <int MODE>
__device__ __forceinline__ void gla_prep(Frame& F, int b, int n, int h) {
    const bf16* proj = (const bf16*)(F.ws + WS_PROJ);
    LAS unsigned char* lds = F.lds; const int tid = F.tid;
    const int dir = tid >> 8, seg = (tid >> 6) & 3, d = tid & 63;
    const size_t tok0 = (size_t)b * SEQ + (size_t)n * 64;
    { const int t = tid >> 3, c4 = (tid & 7) * 4;
      const v2u raw = *(const GAS v2u*)(proj + (tok0 + t) * PP + C_LF + c4);
      *(LAS f32x4*)(lds + LRO + (t * 32 + c4) * 4) = (f32x4){blo(raw.x), bhi(raw.x), blo(raw.y), bhi(raw.y)}; }
#pragma unroll
    for (int it = 0; it < 2; ++it) { const int task = tid + 512 * it, t = task >> 4, ch = task & 15;
      *(LAS v4u*)(lds + VIMG + swzV(t, ch)) = *(const GAS v4u*)(proj + (tok0 + t) * PP + C_GV + h * 128 + ch * 8); }
    const float* W = dir ? F.in[5] : F.in[3]; const float* Bv = dir ? F.in[6] : F.in[4];
    float wr[16];
#pragma unroll
    for (int r = 0; r < 16; ++r) wr[r] = W[r * 256 + h * 64 + d];
    const float bias = Bv[h * 64 + d];
    float kv_[16], qv_[16];
#pragma unroll
    for (int i = 0; i < 16; ++i) { const size_t row = (tok0 + seg * 16 + i) * PP; kv_[i] = bf2f(proj[row + C_GK + h * 64 + d]); if (MODE == 1) qv_[i] = bf2f(proj[row + C_GQ + h * 64 + d]) * 0.125f; }
    __syncthreads();
    float c[16];
#pragma unroll
    for (int i = 0; i < 16; ++i) { const LAS f32x4* lp = (const LAS f32x4*)(lds + LRO + ((seg * 16 + i) * 32 + dir * 16) * 4);
        float z = bias;
#pragma unroll
        for (int r4 = 0; r4 < 4; ++r4) { const f32x4 lv = lp[r4]; z += lv.x * wr[4 * r4] + lv.y * wr[4 * r4 + 1] + lv.z * wr[4 * r4 + 2] + lv.w * wr[4 * r4 + 3]; }
        c[i] = (fminf(z, 0.f) - __builtin_amdgcn_logf(1.0f + fexp(-fabsf(z))) * 0.6931471805599453f) * 0.0625f; }
    if (dir == 0) {
#pragma unroll
        for (int i = 1; i < 16; ++i) c[i] += c[i - 1]; }
    else {
#pragma unroll
        for (int i = 14; i >= 0; --i) c[i] += c[i + 1]; }
    LAS float* segp = (LAS float*)(lds + SEG);
    segp[(dir * 4 + seg) * 64 + d] = dir == 0 ? c[15] : c[0];
    __syncthreads();
    float offs = 0.f, tot = 0.f;
#pragma unroll
    for (int s = 0; s < 4; ++s) { const float sv = segp[(dir * 4 + s) * 64 + d]; tot += sv; if (dir == 0 ? (s < seg) : (s > seg)) offs += sv; }
#pragma unroll
    for (int i = 0; i < 16; ++i) { const int t = seg * 16 + i; const float bb = c[i] + offs;
        const int eo = swz64(t, d >> 3) + (d & 7) * 2;
        if (MODE == 0) { *(LAS bf16*)(lds + IMG + dir * 8192 + eo) = f2bf(kv_[i] * fexp(tot - bb)); }
        else { *(LAS bf16*)(lds + IMG + (2 * dir) * 8192 + eo) = f2bf(qv_[i] * fexp(bb)); *(LAS bf16*)(lds + IMG + (2 * dir + 1) * 8192 + eo) = f2bf(kv_[i] * fexp(-bb)); } }
    if (MODE == 0 && seg == 0) { float* dec = (float*)(F.ws + WS_DEC); dec[((size_t)((b * 4 + h) * 2 + dir) * 128 + n) * 64 + d] = fexp(tot); }
    __syncthreads();
}

__device__ __forceinline__ void gla_unit_a(Frame& F, int unit) {
    const int b = unit >> 9, n = (unit >> 2) & 127, h = unit & 3;
    gla_prep<0>(F, b, n, h);
    LAS unsigned char* lds = F.lds; const int lane = F.lane, w = F.wave;
    const int fr = lane & 15, g = lane >> 4, q4 = fr >> 2, p4 = fr & 3;
    const int dir = w >> 2, vcp = w & 3;
    f32x4 acc[4][2];
#pragma unroll
    for (int dt = 0; dt < 4; ++dt)
#pragma unroll
        for (int v = 0; v < 2; ++v) acc[dt][v] = (f32x4){0.f, 0.f, 0.f, 0.f};
#pragma unroll
    for (int s = 0; s < 2; ++s) {
        const int r0 = 32 * s + 8 * g + q4, r1 = r0 + 4;
        bf16x8 vf[2];
#pragma unroll
        for (int v = 0; v < 2; ++v) { const int ch = 2 * (2 * vcp + v) + (p4 >> 1);
            const s16x4 a0 = vtr(lds + VIMG + swzV(r0, ch) + 8 * (p4 & 1)), a1 = vtr(lds + VIMG + swzV(r1, ch) + 8 * (p4 & 1));
            vf[v] = __builtin_shufflevector(a0, a1, 0, 1, 2, 3, 4, 5, 6, 7); }
#pragma unroll
        for (int dt = 0; dt < 4; ++dt) { const int ch = 2 * dt + (p4 >> 1);
            const s16x4 a0 = vtr(lds + IMG + dir * 8192 + swz64(r0, ch) + 8 * (p4 & 1)), a1 = vtr(lds + IMG + dir * 8192 + swz64(r1, ch) + 8 * (p4 & 1));
            const bf16x8 kf = __builtin_shufflevector(a0, a1, 0, 1, 2, 3, 4, 5, 6, 7);
#pragma unroll
            for (int v = 0; v < 2; ++v) acc[dt][v] = __builtin_amdgcn_mfma_f32_16x16x32_bf16(kf, vf[v], acc[dt][v], 0, 0, 0); }
    }
    bf16* kvb = (bf16*)(F.ws + WS_KV) + ((size_t)((b * 4 + h) * 2 + dir) * 128 + n) * 8192;
#pragma unroll
    for (int dt = 0; dt < 4; ++dt)
#pragma unroll
        for (int v = 0; v < 2; ++v) { const int vc = 16 * (2 * vcp + v) + fr; v2u o; o.x = cvtpk(acc[dt][v][0], acc[dt][v][1]); o.y = cvtpk(acc[dt][v][2], acc[dt][v][3]);
            *(GAS v2u*)(kvb + vc * 64 + 16 * dt + 4 * g) = o; }
    __syncthreads();
}

__device__ __forceinline__ void gla_scan(Frame& F) {
    if (F.tid >= 256) return;
    for (int e2 = blockIdx.x * 256 + F.tid; e2 < 65536; e2 += F.G * 256) {
    const int combo = e2 >> 12, rem = e2 & 4095, d2 = rem & 31, dir = combo & 1;
    unsigned* kvw = (unsigned*)(F.ws + WS_KV) + (size_t)combo * 128 * 4096 + rem;
    const float* dec = (const float*)(F.ws + WS_DEC) + (size_t)combo * 128 * 64 + 2 * d2;
    float s0 = 0.f, s1 = 0.f;
    for (int nb = 0; nb < 128; nb += 8) {
        unsigned kvr[8]; float2 dc[8];
#pragma unroll
        for (int j = 0; j < 8; ++j) { const int n = dir ? (127 - nb - j) : (nb + j); kvr[j] = kvw[(size_t)n * 4096]; dc[j] = *(const float2*)(dec + n * 64); }
#pragma unroll
        for (int j = 0; j < 8; ++j) { const int n = dir ? (127 - nb - j) : (nb + j);
            kvw[(size_t)n * 4096] = pk2(s0, s1);
            s0 = s0 * dc[j].x + blo(kvr[j]); s1 = s1 * dc[j].y + bhi(kvr[j]); }
    }
    }
}

__device__ __forceinline__ void gla_unit_c(Frame& F, int unit) {
    const int b = unit >> 9, n = (unit >> 2) & 127, h = unit & 3;
    gla_prep<1>(F, b, n, h);
    const bf16* proj = (const bf16*)(F.ws + WS_PROJ);
    LAS unsigned char* lds = F.lds; const int lane = F.lane, w = F.wave;
    const int fr = lane & 15, g = lane >> 4, q4 = fr >> 2, p4 = fr & 3;
    const int tt = w & 3, vh = w >> 2;
    f32x4 o[4];
#pragma unroll
    for (int vt = 0; vt < 4; ++vt) o[vt] = (f32x4){0.f, 0.f, 0.f, 0.f};
    const int tq = 16 * tt + fr;
#pragma unroll
    for (int dir = 0; dir < 2; ++dir) {
        bf16x8 qf[2];
#pragma unroll
        for (int s = 0; s < 2; ++s) qf[s] = *(const LAS bf16x8*)(lds + IMG + (2 * dir) * 8192 + swz64(tq, 4 * s + g));
        f32x4 st[4];
#pragma unroll
        for (int ut = 0; ut < 4; ++ut) { st[ut] = (f32x4){0.f, 0.f, 0.f, 0.f};
#pragma unroll
            for (int s = 0; s < 2; ++s) { const bf16x8 kf = *(const LAS bf16x8*)(lds + IMG + (2 * dir + 1) * 8192 + swz64(16 * ut + fr, 4 * s + g));
                st[ut] = __builtin_amdgcn_mfma_f32_16x16x32_bf16(kf, qf[s], st[ut], 0, 0, 0); }
#pragma unroll
            for (int i = 0; i < 4; ++i) { const int u = 16 * ut + 4 * g + i; const bool keep = dir == 0 ? (u <= tq) : (u >= tq); st[ut][i] = keep ? st[ut][i] : 0.f; } }
        const bf16* stb = (const bf16*)(F.ws + WS_KV) + ((size_t)((b * 4 + h) * 2 + dir) * 128 + n) * 8192;
#pragma unroll
        for (int kp = 0; kp < 2; ++kp) {
            v4u pw; pw.x = cvtpk(st[2 * kp][0], st[2 * kp][1]); pw.y = cvtpk(st[2 * kp][2], st[2 * kp][3]);
            pw.z = cvtpk(st[2 * kp + 1][0], st[2 * kp + 1][1]); pw.w = cvtpk(st[2 * kp + 1][2], st[2 * kp + 1][3]);
            const bf16x8 pf = __builtin_bit_cast(bf16x8, pw);
            const int r0 = 32 * kp + 4 * g + q4, r1 = r0 + 16;
#pragma unroll
            for (int vt = 0; vt < 4; ++vt) { const int ch = 8 * vh + 2 * vt + (p4 >> 1);
                const s16x4 a0 = vtr(lds + VIMG + swzV(r0, ch) + 8 * (p4 & 1)), a1 = vtr(lds + VIMG + swzV(r1, ch) + 8 * (p4 & 1));
                const bf16x8 af = __builtin_shufflevector(a0, a1, 0, 1, 2, 3, 4, 5, 6, 7);
                o[vt] = __builtin_amdgcn_mfma_f32_16x16x32_bf16(af, pf, o[vt], 0, 0, 0); }
        }
#pragma unroll
        for (int s = 0; s < 2; ++s)
#pragma unroll
            for (int vt = 0; vt < 4; ++vt) { const bf16x8 sf = *(const GAS bf16x8*)(stb + (size_t)(64 * vh + 16 * vt + fr) * 64 + 32 * s + 8 * g);
                o[vt] = __builtin_amdgcn_mfma_f32_16x16x32_bf16(sf, qf[s], o[vt], 0, 0, 0); }
    }
    float ss = 0.f;
#pragma unroll
    for (int vt = 0; vt < 4; ++vt) ss += (o[vt][0] * o[vt][0] + o[vt][1] * o[vt][1]) + (o[vt][2] * o[vt][2] + o[vt][3] * o[vt][3]);
    ss += __shfl_xor(ss, 16); ss += __shfl_xor(ss, 32);
    LAS float* ssq = (LAS float*)(lds + SSQ);
    if (g == 0) ssq[vh * 64 + tq] = ss;
    __syncthreads();
    const float rstd = rsqrtf((ssq[tq] + ssq[64 + tq]) * (1.0f / 128.0f) + 1e-6f);
    const size_t tok = (size_t)b * SEQ + (size_t)n * 64 + tq;
    bf16* mixed = (bf16*)(F.ws + WS_U);
#pragma unroll
    for (int vt = 0; vt < 4; ++vt) { const int vc = 64 * vh + 16 * vt + 4 * g;
        const v2u gr = *(const GAS v2u*)(proj + tok * PP + C_GG + h * 128 + vc); const f32x4 nw = *(const GAS f32x4*)(F.in[7] + vc);
        const float g0 = blo(gr.x), g1 = bhi(gr.x), g2 = blo(gr.y), g3 = bhi(gr.y);
        v2u ov; ov.x = cvtpk(pg8::silu_mul(g0, o[vt][0] * rstd * nw.x), pg8::silu_mul(g1, o[vt][1] * rstd * nw.y));
        ov.y = cvtpk(pg8::silu_mul(g2, o[vt][2] * rstd * nw.z), pg8::silu_mul(g3, o[vt][3] * rstd * nw.w));
        *(GAS v2u*)(mixed + tok * D + h * 128 + vc) = ov; }
    __syncthreads();
}
constexpr int RQO = 61440, RKO = 69632;
struct GRegs { v4u q, k, v0, v1; v2u lr; };
template <int MODE>
__device__ __forceinline__ void gla_load(const Frame& F, int unit, GRegs& r) {
    const bf16* proj = (const bf16*)(F.ws + WS_PROJ);
    const int b = unit >> 9, n = (unit >> 2) & 127, h = unit & 3, tid = F.tid;
    const size_t tok0 = (size_t)b * SEQ + (size_t)n * 64;
    { const int t = tid >> 3, ch = tid & 7; const bf16* src = proj + (tok0 + t) * PP + h * 64 + ch * 8;
      r.k = *(const GAS v4u*)(src + C_GK); if (MODE == 1) r.q = *(const GAS v4u*)(src + C_GQ);
      r.lr = *(const GAS v2u*)(proj + (tok0 + t) * PP + C_LF + ch * 4); }
    { const int t0 = tid >> 4, ch = tid & 15; r.v0 = *(const GAS v4u*)(proj + (tok0 + t0) * PP + C_GV + h * 128 + ch * 8); r.v1 = *(const GAS v4u*)(proj + (tok0 + t0 + 32) * PP + C_GV + h * 128 + ch * 8); }
}
template <int MODE>
__device__ __forceinline__ void gla_store_raw(const Frame& F, const GRegs& r) {
    LAS unsigned char* lds = F.lds; const int tid = F.tid;
    { const int t = tid >> 3, ch = tid & 7;
      *(LAS v4u*)(lds + RKO + t * 128 + ch * 16) = r.k; if (MODE == 1) *(LAS v4u*)(lds + RQO + t * 128 + ch * 16) = r.q;
      *(LAS f32x4*)(lds + LRO + (t * 32 + ch * 4) * 4) = (f32x4){blo(r.lr.x), bhi(r.lr.x), blo(r.lr.y), bhi(r.lr.y)}; }
    { const int t0 = tid >> 4, ch = tid & 15; *(LAS v4u*)(lds + VIMG + swzV(t0, ch)) = r.v0; *(LAS v4u*)(lds + VIMG + swzV(t0 + 32, ch)) = r.v1; }
}
template <int MODE>
__device__ __forceinline__ void gla_images(const Frame& F, int b, int n, int h, const float (&wr)[16], float bias) {
    LAS unsigned char* lds = F.lds; const int tid = F.tid;
    const int dir = tid >> 8, seg = (tid >> 6) & 3, d = tid & 63;
    float c[16];
#pragma unroll
    for (int i = 0; i < 16; ++i) { const LAS f32x4* lp = (const LAS f32x4*)(lds + LRO + ((seg * 16 + i) * 32 + dir * 16) * 4);
        float z = bias;
#pragma unroll
        for (int r4 = 0; r4 < 4; ++r4) { const f32x4 lv = lp[r4]; z += lv.x * wr[4 * r4] + lv.y * wr[4 * r4 + 1] + lv.z * wr[4 * r4 + 2] + lv.w * wr[4 * r4 + 3]; }
        c[i] = (fminf(z, 0.f) - __builtin_amdgcn_logf(1.0f + fexp(-fabsf(z))) * 0.6931471805599453f) * 0.0625f; }
    if (dir == 0) {
#pragma unroll
        for (int i = 1; i < 16; ++i) c[i] += c[i - 1]; }
    else {
#pragma unroll
        for (int i = 14; i >= 0; --i) c[i] += c[i + 1]; }
    LAS float* segp = (LAS float*)(lds + SEG);
    segp[(dir * 4 + seg) * 64 + d] = dir == 0 ? c[15] : c[0];
    __syncthreads();
    float offs = 0.f, tot = 0.f;
#pragma unroll
    for (int s = 0; s < 4; ++s) { const float sv = segp[(dir * 4 + s) * 64 + d]; tot += sv; if (dir == 0 ? (s < seg) : (s > seg)) offs += sv; }
#pragma unroll
    for (int i = 0; i < 16; ++i) { const int t = seg * 16 + i; const float bb = c[i] + offs;
        const int eo = swz64(t, d >> 3) + (d & 7) * 2;
        const float kv_ = bf2f(*(const LAS bf16*)(lds + RKO + t * 128 + d * 2));
        if (MODE == 0) { *(LAS bf16*)(lds + IMG + dir * 8192 + eo) = f2bf(kv_ * fexp(tot - bb)); }
        else { const float qv_ = bf2f(*(const LAS bf16*)(lds + RQO + t * 128 + d * 2)) * 0.125f; const float e = fexp(bb);
            *(LAS bf16*)(lds + IMG + (2 * dir) * 8192 + eo) = f2bf(qv_ * e); *(LAS bf16*)(lds + IMG + (2 * dir + 1) * 8192 + eo) = f2bf(kv_ * __builtin_amdgcn_rcpf(e)); } }
    if (MODE == 0 && seg == 0) { float* dec = (float*)(F.ws + WS_DEC); dec[((size_t)((b * 4 + h) * 2 + dir) * 128 + n) * 64 + d] = fexp(tot); }
    __syncthreads();
}

__device__ __forceinline__ void gla_phase_a(Frame& F) {
    LAS unsigned char* lds = F.lds; const int lane = F.lane, w = F.wave, tid = F.tid;
    const int fr = lane & 15, g = lane >> 4, q4 = fr >> 2, p4 = fr & 3;
    const int pdir = tid >> 8, pd = tid & 63;
    GRegs rg; int hprev = -1; float wr[16]; float bias = 0.f;
    int u = blockIdx.x;
    if (u < 1024) gla_load<0>(F, u, rg);
    for (; u < 1024; u += F.G) {
        const int b = u >> 9, n = (u >> 2) & 127, h = u & 3;
        gla_store_raw<0>(F, rg);
        if (h != hprev) { const float* W = pdir ? F.in[5] : F.in[3]; const float* Bv = pdir ? F.in[6] : F.in[4];
#pragma unroll
            for (int r = 0; r < 16; ++r) wr[r] = W[r * 256 + h * 64 + pd];
            bias = Bv[h * 64 + pd]; hprev = h; }
        __syncthreads();
        if (u + F.G < 1024) gla_load<0>(F, u + F.G, rg);
        gla_images<0>(F, b, n, h, wr, bias);
        const int dir = w >> 2, vcp = w & 3;
        f32x4 acc[4][2];
#pragma unroll
        for (int dt = 0; dt < 4; ++dt)
#pragma unroll
            for (int v = 0; v < 2; ++v) acc[dt][v] = (f32x4){0.f, 0.f, 0.f, 0.f};
#pragma unroll
        for (int s = 0; s < 2; ++s) {
            const int r0 = 32 * s + 8 * g + q4, r1 = r0 + 4;
            bf16x8 vf[2];
#pragma unroll
            for (int v = 0; v < 2; ++v) { const int ch = 2 * (2 * vcp + v) + (p4 >> 1);
                const s16x4 a0 = vtr(lds + VIMG + swzV(r0, ch) + 8 * (p4 & 1)), a1 = vtr(lds + VIMG + swzV(r1, ch) + 8 * (p4 & 1));
                vf[v] = __builtin_shufflevector(a0, a1, 0, 1, 2, 3, 4, 5, 6, 7); }
#pragma unroll
            for (int dt = 0; dt < 4; ++dt) { const int ch = 2 * dt + (p4 >> 1);
                const s16x4 a0 = vtr(lds + IMG + dir * 8192 + swz64(r0, ch) + 8 * (p4 & 1)), a1 = vtr(lds + IMG + dir * 8192 + swz64(r1, ch) + 8 * (p4 & 1));
                const bf16x8 kf = __builtin_shufflevector(a0, a1, 0, 1, 2, 3, 4, 5, 6, 7);
#pragma unroll
                for (int v = 0; v < 2; ++v) acc[dt][v] = __builtin_amdgcn_mfma_f32_16x16x32_bf16(kf, vf[v], acc[dt][v], 0, 0, 0); }
        }
        bf16* kvb = (bf16*)(F.ws + WS_KV) + ((size_t)((b * 4 + h) * 2 + dir) * 128 + n) * 8192;
#pragma unroll
        for (int dt = 0; dt < 4; ++dt)
#pragma unroll
            for (int v = 0; v < 2; ++v) { const int vc = 16 * (2 * vcp + v) + fr; v2u o; o.x = cvtpk(acc[dt][v][0], acc[dt][v][1]); o.y = cvtpk(acc[dt][v][2], acc[dt][v][3]);
                *(GAS v2u*)(kvb + vc * 64 + 16 * dt + 4 * g) = o; }
        __syncthreads();
    }
}

__device__ __forceinline__ void gla_phase_c(Frame& F) {
    const bf16* proj = (const bf16*)(F.ws + WS_PROJ);
    LAS unsigned char* lds = F.lds; const int lane = F.lane, w = F.wave, tid = F.tid;
    const int fr = lane & 15, g = lane >> 4, q4 = fr >> 2, p4 = fr & 3;
    const int tt = w & 3, vh = w >> 2, tq = 16 * tt + fr;
    const int pdir = tid >> 8, pd = tid & 63;
    GRegs rg; int hprev = -1; float wr[16]; float bias = 0.f;
    int u = blockIdx.x;
    if (u < 1024) gla_load<1>(F, u, rg);
    for (; u < 1024; u += F.G) {
        const int b = u >> 9, n = (u >> 2) & 127, h = u & 3;
        gla_store_raw<1>(F, rg);
        if (h != hprev) { const float* W = pdir ? F.in[5] : F.in[3]; const float* Bv = pdir ? F.in[6] : F.in[4];
#pragma unroll
            for (int r = 0; r < 16; ++r) wr[r] = W[r * 256 + h * 64 + pd];
            bias = Bv[h * 64 + pd]; hprev = h; }
        __syncthreads();
        if (u + F.G < 1024) gla_load<1>(F, u + F.G, rg);
        bf16x8 sf[2][2][4];
#pragma unroll
        for (int dir = 0; dir < 2; ++dir) { const bf16* stb = (const bf16*)(F.ws + WS_KV) + ((size_t)((b * 4 + h) * 2 + dir) * 128 + n) * 8192;
#pragma unroll
            for (int s = 0; s < 2; ++s)
#pragma unroll
                for (int vt = 0; vt < 4; ++vt) sf[dir][s][vt] = *(const GAS bf16x8*)(stb + (size_t)(64 * vh + 16 * vt + fr) * 64 + 32 * s + 8 * g); }
        const size_t tok = (size_t)b * SEQ + (size_t)n * 64 + tq;
        v2u gr[4]; f32x4 nwv[4];
#pragma unroll
        for (int vt = 0; vt < 4; ++vt) { const int vc = 64 * vh + 16 * vt + 4 * g; gr[vt] = *(const GAS v2u*)(proj + tok * PP + C_GG + h * 128 + vc); nwv[vt] = *(const GAS f32x4*)(F.in[7] + vc); }
        gla_images<1>(F, b, n, h, wr, bias);
        f32x4 o[4];
#pragma unroll
        for (int vt = 0; vt < 4; ++vt) o[vt] = (f32x4){0.f, 0.f, 0.f, 0.f};
#pragma unroll
        for (int dir = 0; dir < 2; ++dir) {
            bf16x8 qf[2];
#pragma unroll
            for (int s = 0; s < 2; ++s) qf[s] = *(const LAS bf16x8*)(lds + IMG + (2 * dir) * 8192 + swz64(tq, 4 * s + g));
            f32x4 st[4];
#pragma unroll
            for (int ut = 0; ut < 4; ++ut) { st[ut] = (f32x4){0.f, 0.f, 0.f, 0.f};
#pragma unroll
                for (int s = 0; s < 2; ++s) { const bf16x8 kf = *(const LAS bf16x8*)(lds + IMG + (2 * dir + 1) * 8192 + swz64(16 * ut + fr, 4 * s + g));
                    st[ut] = __builtin_amdgcn_mfma_f32_16x16x32_bf16(kf, qf[s], st[ut], 0, 0, 0); }
#pragma unroll
                for (int i = 0; i < 4; ++i) { const int uu = 16 * ut + 4 * g + i; const bool keep = dir == 0 ? (uu <= tq) : (uu >= tq); st[ut][i] = keep ? st[ut][i] : 0.f; } }
#pragma unroll
            for (int kp = 0; kp < 2; ++kp) {
                v4u pw; pw.x = cvtpk(st[2 * kp][0], st[2 * kp][1]); pw.y = cvtpk(st[2 * kp][2], st[2 * kp][3]);
                pw.z = cvtpk(st[2 * kp + 1][0], st[2 * kp + 1][1]); pw.w = cvtpk(st[2 * kp + 1][2], st[2 * kp + 1][3]);
                const bf16x8 pf = __builtin_bit_cast(bf16x8, pw);
                const int r0 = 32 * kp + 4 * g + q4, r1 = r0 + 16;
#pragma unroll
                for (int vt = 0; vt < 4; ++vt) { const int ch = 8 * vh + 2 * vt + (p4 >> 1);
                    const s16x4 a0 = vtr(lds + VIMG + swzV(r0, ch) + 8 * (p4 & 1)), a1 = vtr(lds + VIMG + swzV(r1, ch) + 8 * (p4 & 1));
                    const bf16x8 af = __builtin_shufflevector(a0, a1, 0, 1, 2, 3, 4, 5, 6, 7);
                    o[vt] = __builtin_amdgcn_mfma_f32_16x16x32_bf16(af, pf, o[vt], 0, 0, 0); }
            }
#pragma unroll
            for (int s = 0; s < 2; ++s)
#pragma unroll
                for (int vt = 0; vt < 4; ++vt) o[vt] = __builtin_amdgcn_mfma_f32_16x16x32_bf16(sf[dir][s][vt], qf[s], o[vt], 0, 0, 0);
        }
        float ss = 0.f;
#pragma unroll
        for (int vt = 0; vt < 4; ++vt) ss += (o[vt][0] * o[vt][0] + o[vt][1] * o[vt][1]) + (o[vt][2] * o[vt][2] + o[vt][3] * o[vt][3]);
        ss += __shfl_xor(ss, 16); ss += __shfl_xor(ss, 32);
        LAS float* ssq = (LAS float*)(lds + SSQ);
        if (g == 0) ssq[vh * 64 + tq] = ss;
        __syncthreads();
        const float rstd = rsqrtf((ssq[tq] + ssq[64 + tq]) * (1.0f / 128.0f) + 1e-6f);
        bf16* mixed = (bf16*)(F.ws + WS_U);
#pragma unroll
        for (int vt = 0; vt < 4; ++vt) { const int vc = 64 * vh + 16 * vt + 4 * g;
            const float g0 = blo(gr[vt].x), g1 = bhi(gr[vt].x), g2 = blo(gr[vt].y), g3 = bhi(gr[vt].y);
            v2u ov; ov.x = cvtpk(pg8::silu_mul(g0, o[vt][0] * rstd * nwv[vt].x), pg8::silu_mul(g1, o[vt][1] * rstd * nwv[vt].y));
            ov.y = cvtpk(pg8::silu_mul(g2, o[vt][2] * rstd * nwv[vt].z), pg8::silu_mul(g3, o[vt][3] * rstd * nwv[vt].w));
            *(GAS v2u*)(mixed + tok * D + h * 128 + vc) = ov; }
    }
    __syncthreads();
}
}

struct Args { const float* in[18]; float* out; unsigned char* ws; int ph_lo, ph_hi, li, pad; };
__global__ void __launch_bounds__(NWAVES * 64, 2) mk_fwd(Args args) {
    extern __shared__ __attribute__((aligned(16))) unsigned char lds[];
    Frame F;
    F.lds = (LAS unsigned char*)lds;
    F.MISC = (volatile LAS unsigned*)(F.lds + MISC_OFF);
    F.tid = threadIdx.x; F.lane = F.tid & 63; F.wave = __builtin_amdgcn_readfirstlane(F.tid >> 6);
    F.G = gridDim.x; { const int bx = blockIdx.x; F.vcu = (F.G % 8 == 0) ? (bx % 8) * (F.G / 8) + bx / 8 : bx; }
    F.ws = args.ws; F.out = args.out; F.ctl = (gu32*)(args.ws + WS_CTL);
#pragma unroll
    for (int i = 0; i < 18; ++i) F.in[i] = args.in[i];
    for (int u = F.tid; u < (LDS_BYTES - TAB_OFF) / 4; u += NWAVES * 64) ((LAS unsigned*)(F.lds + TAB_OFF))[u] = 0u;
    __syncthreads();
    XcdBarrier bar = xcd_barrier_post((unsigned*)(F.ctl + CW_BAR) + args.li * XCD_BAR_WORDS, F.MISC + 8);
    const int lo = args.ph_lo, hi = args.ph_hi;
#define IN(k) (lo <= (k) && (k) < hi)
#define BOTH(k) (IN(k) && IN((k) + 1))
#define GRID_BAR() xcd_barrier(bar)

#ifndef REP0
#define REP0 1
#define REP1 1
#define REP2 1
#define REP4 1
#define REP5 1
#define REP7 1
#define REP8 1
#define REP6R 1
#define REPBAR 0
#define REP2G 1
#define REP2A 1
#define REP3 1
#define REP6C 1
#define REP9 1
#define REP4G 1
#define REP4M 1
#endif
    if (IN(0)) { _Pragma("unroll") for (int rep = 0; rep < REP0; ++rep) p0_prologue(F); if (BOTH(0)) GRID_BAR(); }

    if (IN(1)) _Pragma("unroll") for (int rep = 0; rep < REP1; ++rep) {
        pg8::StaticOrder S; S.init(F.ws + WS_U, F.ws + WS_WIN, T, PP, D, F.G, (int)blockIdx.x);
        pg8::EpiProj E{(bf16*)(F.ws + WS_PROJ), PP, (const float*)(F.ws + WS_ROPE)};
        pg8::gemm_phase<pg8::EpiProj, pg8::StaticOrder, false, true>(F.lds + RING_OFF, D, S, E);
    }
    if (BOTH(1)) GRID_BAR();

    if (IN(2)) { _Pragma("unroll") for (int rep = 0; rep < REP2; ++rep) {
        _Pragma("unroll") for (int r2 = 0; r2 < REP2G; ++r2) gla::gla_phase_a(F);
        _Pragma("unroll") for (int r2 = 0; r2 < REP2A; ++r2) att::attn_phase(F); }
        if (BOTH(2)) GRID_BAR(); }

    if (IN(3)) { gla::gla_scan(F);
        _Pragma("unroll") for (int r3 = 1; r3 < REP3; ++r3) { GRID_BAR(); gla::gla_phase_a(F); GRID_BAR(); gla::gla_scan(F); }
        if (BOTH(3)) GRID_BAR(); }

    if (IN(4)) { _Pragma("unroll") for (int rep = 0; rep < REP4; ++rep) {
        _Pragma("unroll") for (int r2 = 0; r2 < REP4G; ++r2) gla::gla_phase_c(F);
        _Pragma("unroll") for (int r2 = 0; r2 < REP4M; ++r2) att::attn_merge(F); }
        if (BOTH(4)) GRID_BAR(); }

    if (IN(5)) _Pragma("unroll") for (int rep = 0; rep < REP5; ++rep) {
        pg8::StaticOrder S; S.init(F.ws + WS_U, F.ws + WS_WOUT, T, D, D, F.G, (int)blockIdx.x);
        pg8::EpiBf16Res E{(bf16*)(F.ws + WS_H1), F.in[0], D};
        pg8::gemm_phase<pg8::EpiBf16Res, pg8::StaticOrder, false, false>(F.lds + RING_OFF, D, S, E);
    }
    if (BOTH(5)) GRID_BAR();

    if (IN(6)) { _Pragma("unroll") for (int r6 = 1; r6 < REP6R; ++r6) { p6_router(F, true); __syncthreads(); } p6_router(F, false); _Pragma("unroll") for (int r6 = 0; r6 < REPBAR; ++r6) GRID_BAR(); _Pragma("unroll") for (int r6 = 0; r6 < REP6C; ++r6) p6_convert(F); if (BOTH(6)) GRID_BAR(); }

    if (IN(7)) _Pragma("unroll") for (int rep = 0; rep < REP7; ++rep) {
        const int NT = moe_build_tab(F);
        pg8::MoeOrder<true> S{(const char*)(F.ws + WS_U), (const char*)(F.ws + WS_WGU), (size_t)1024 * 1024 * 2, D, NT * 4, F.G, (int)blockIdx.x,
                              (const LAS int*)(F.lds + TAB_OFF), (const unsigned*)(F.ctl + CW_CNT), (const int*)(F.ws + WS_LIST)};
        pg8::EpiGateUp E{(bf16*)(F.ws + WS_ACT)};
        pg8::gemm_phase<pg8::EpiGateUp, pg8::MoeOrder<true>, true, true>(F.lds + RING_OFF, D, S, E);
    }
    if (BOTH(7)) GRID_BAR();

    if (IN(8)) _Pragma("unroll") for (int rep = 0; rep < REP8; ++rep) {
        const int NT = moe_build_tab(F);
        pg8::MoeOrder<false> S{(const char*)(F.ws + WS_ACT), (const char*)(F.ws + WS_WD), (size_t)1024 * 512 * 2, 512, NT * 4, F.G, (int)blockIdx.x,
                               (const LAS int*)(F.lds + TAB_OFF), (const unsigned*)(F.ctl + CW_CNT), (const int*)(F.ws + WS_LIST)};
        pg8::EpiDown E{(bf16*)(F.ws + WS_YBUF), (const int*)(F.ws + WS_LIST), (const unsigned*)(F.ctl + CW_CNT), (const float*)(F.ws + WS_WGT)};
        pg8::gemm_phase<pg8::EpiDown, pg8::MoeOrder<false>, false, true>(F.lds + RING_OFF, 512, S, E);
    }
    if (BOTH(8)) GRID_BAR();

    if (IN(9)) { _Pragma("unroll") for (int r9 = 1; r9 < REP9; ++r9) p9_final(F, (float*)(F.ws + WS_WD)); p9_final(F, F.out); }
#undef IN
#undef BOTH
#undef GRID_BAR
}

static void launch_mk(const Args& base, int lo, int hi, int li, int grid, hipStream_t stream, int sub = 3) {
    Args a = base; a.ph_lo = lo; a.ph_hi = hi; a.li = li; a.pad = sub;
    hipLaunchKernelGGL(mk_fwd, dim3(grid), dim3(NWAVES * 64), LDS_BYTES, stream, a);
}
extern "C" void kernel_launch(void* const* d_in, const int* in_sizes, int n_in, void* d_out, int out_size, void* d_ws, size_t ws_size, hipStream_t stream) {
    static int grid = 0;
    if (grid == 0) {
        int dev = 0, cus = 0;
        if (hipGetDevice(&dev) != hipSuccess || hipDeviceGetAttribute(&cus, hipDeviceAttributeMultiprocessorCount, dev) != hipSuccess) { grid = -1; return; }
        if (hipFuncSetAttribute((const void*)mk_fwd, hipFuncAttributeMaxDynamicSharedMemorySize, LDS_BYTES) != hipSuccess) { fprintf(stderr, "kernel_launch: hipFuncSetAttribute failed\n"); grid = -1; return; }
        (void)hipGetLastError();
        grid = cus;
    }
    if (grid < 0) return;
    unsigned char* ws = (unsigned char*)d_ws; float* out = (float*)d_out;
    (void)hipMemsetAsync(ws + WS_CTL, 0, 1 * MiB, stream);
    Args a{};
    for (int i = 0; i < 18; ++i) a.in[i] = (const float*)d_in[i];
    a.out = out; a.ws = ws;
    launch_mk(a, 0, 10, 0, grid, stream, 3);
}
```
